# Optimizing an MI355X kernel written in HIP

```python
import jax, jax.numpy as jnp
from jax import lax
import numpy as np

D_MODEL = 4096
BATCH = 8
SEQ = 2048
DEPTH = 2
DEC_BATCH = 2
DEC_SEQ = 4096
PAST_LEN = 128

N_MIXERS = 2
N_A_LAYERS = (DEPTH + 1) // 2
N_B_LAYERS = DEPTH // 2
CHUNK = 128
D_U = D_MODEL
A_HEADS = 32
A_HEAD_DIM = D_U // A_HEADS
B_GROUPS = 8
B_GROUP_DIM = D_MODEL // B_GROUPS
D_FF = -(-8 * D_MODEL // (3 * 256)) * 256
EPS = 1e-6

kernel_name = "hybrid_gmlp_fnet_encoder"


def rmsnorm(x, g):
    xf = x.astype(jnp.float32)
    r = lax.rsqrt(jnp.mean(xf * xf, axis=-1, keepdims=True) + EPS)
    return (xf * r * g.astype(jnp.float32)).astype(x.dtype)


def layernorm(x, g, b):
    xf = x.astype(jnp.float32)
    mu = jnp.mean(xf, axis=-1, keepdims=True)
    xc = xf - mu
    r = lax.rsqrt(jnp.mean(xc * xc, axis=-1, keepdims=True) + EPS)
    return (xc * r * g.astype(jnp.float32) + b.astype(jnp.float32)).astype(x.dtype)


def gmlp_mixer(h, w_in, ln_g, ln_b, w_s, b_s, w_out):
    B, S, _ = h.shape
    z = jax.nn.gelu(h @ w_in)
    u, v = jnp.split(z, 2, axis=-1)
    v = layernorm(v, ln_g, ln_b)
    v = v.reshape(B, S // CHUNK, CHUNK, A_HEADS, A_HEAD_DIM)
    s = jnp.einsum('hpq,bcqhd->bcphd', w_s, v) + jnp.transpose(b_s)[None, None, :, :, None]
    s = s.reshape(B, S, D_U)
    return (u * s) @ w_out


def fourier_mixer(h, w_out):
    B, S, D = h.shape
    hf = h.astype(jnp.float32).reshape(B, S, B_GROUPS, B_GROUP_DIM)
    y = jnp.fft.fft2(hf, axes=(1, 3), norm='ortho').real
    y = y.astype(h.dtype).reshape(B, S, D)
    return y @ w_out


def swiglu(h, w_gate, w_up, w_down):
    return (jax.nn.silu(h @ w_gate) * (h @ w_up)) @ w_down


def trunk(x, a_norm_g, a_w_in, a_ln_g, a_ln_b, a_w_s, a_b_s, a_w_out,
          b_norm_g, b_w_out, ffn_norm_g, ffn_w_gate, ffn_w_up, ffn_w_down, final_norm_g):
    for i in range(DEPTH):
        j = i // N_MIXERS
        if i % N_MIXERS == 0:
            x = x + gmlp_mixer(rmsnorm(x, a_norm_g[j]), a_w_in[j], a_ln_g[j], a_ln_b[j],
                               a_w_s[j], a_b_s[j], a_w_out[j])
        else:
            x = x + fourier_mixer(rmsnorm(x, b_norm_g[j]), b_w_out[j])
        x = x + swiglu(rmsnorm(x, ffn_norm_g[i]), ffn_w_gate[i], ffn_w_up[i], ffn_w_down[i])
    return rmsnorm(x, final_norm_g)


def setup_inputs(seed: int = 0) -> dict:
    key = jax.random.key(seed)
    ks = jax.random.split(key, 20)

    def nrm(k, shape, scale):
        return jax.random.normal(k, shape, jnp.float32) * scale

    return {
        "x_prompt": nrm(ks[0], (BATCH, SEQ, D_MODEL), 1.0),
        "x_sample": nrm(ks[1], (DEC_BATCH, DEC_SEQ, D_MODEL), 1.0),
        "a_norm_g": 1.0 + nrm(ks[2], (N_A_LAYERS, D_MODEL), 0.02),
        "a_w_in": nrm(ks[3], (N_A_LAYERS, D_MODEL, 2 * D_U), D_MODEL ** -0.5),
        "a_ln_g": 1.0 + nrm(ks[4], (N_A_LAYERS, D_U), 0.02),
        "a_ln_b": nrm(ks[5], (N_A_LAYERS, D_U), 0.02),
        "a_w_s": nrm(ks[6], (N_A_LAYERS, A_HEADS, CHUNK, CHUNK), CHUNK ** -0.5),
        "a_b_s": 1.0 + nrm(ks[7], (N_A_LAYERS, A_HEADS, CHUNK), 0.02),
        "a_w_out": nrm(ks[8], (N_A_LAYERS, D_U, D_MODEL), D_U ** -0.5),
        "b_norm_g": 1.0 + nrm(ks[9], (N_B_LAYERS, D_MODEL), 0.02),
        "b_w_out": nrm(ks[10], (N_B_LAYERS, D_MODEL, D_MODEL), D_MODEL ** -0.5),
        "ffn_norm_g": 1.0 + nrm(ks[11], (DEPTH, D_MODEL), 0.02),
        "ffn_w_gate": nrm(ks[12], (DEPTH, D_MODEL, D_FF), D_MODEL ** -0.5),
        "ffn_w_up": nrm(ks[13], (DEPTH, D_MODEL, D_FF), D_MODEL ** -0.5),
        "ffn_w_down": nrm(ks[14], (DEPTH, D_FF, D_MODEL), D_FF ** -0.5),
        "final_norm_g": 1.0 + nrm(ks[15], (D_MODEL,), 0.02),
    }


def reference(x_prompt, x_sample, a_norm_g, a_w_in, a_ln_g, a_ln_b, a_w_s, a_b_s, a_w_out,
              b_norm_g, b_w_out, ffn_norm_g, ffn_w_gate, ffn_w_up, ffn_w_down, final_norm_g):
    y_prompt = trunk(x_prompt, a_norm_g, a_w_in, a_ln_g, a_ln_b, a_w_s, a_b_s, a_w_out,
                     b_norm_g, b_w_out, ffn_norm_g, ffn_w_gate, ffn_w_up, ffn_w_down, final_norm_g)
    y_sample = trunk(x_sample, a_norm_g, a_w_in, a_ln_g, a_ln_b, a_w_s, a_b_s, a_w_out,
                     b_norm_g, b_w_out, ffn_norm_g, ffn_w_gate, ffn_w_up, ffn_w_down, final_norm_g)
    return (y_prompt, y_sample)
```

```cpp
#include <hip/hip_runtime.h>
#include <cstdio>
#include <cstdint>

#ifndef MK_N_LAUNCHES
#define MK_N_LAUNCHES 1
#endif

namespace pg8 {
#define PG8_LAS __attribute__((address_space(3)))
typedef unsigned short bf16_t;
typedef short bf16x8 __attribute__((ext_vector_type(8)));
typedef float f32x4 __attribute__((ext_vector_type(4)));
typedef float f32x2 __attribute__((ext_vector_type(2)));
typedef unsigned u32x4 __attribute__((ext_vector_type(4)));
typedef unsigned u32x2 __attribute__((ext_vector_type(2)));
constexpr int BM = 256, BK = 64, HALF = 128, HTB = HALF * BK * 2  , STAGE_BYTES = 8 * HTB, NXCD = 8, WGM = 8;

__host__ __device__ __forceinline__ int lds_byte(int r, int c) { const int st = (r >> 4) * 2 + (c >> 5), rr = r & 15, cc = c & 31, ob = rr * 64 + cc * 2; return st * 1024 + (ob ^ (((ob >> 9) & 1) << 5)); }
__host__ __device__ __forceinline__ void stage_rc(int b, int& R, int& C) { const int st = b / 1024, sb = b % 1024, swz = sb ^ (((sb >> 9) & 1) << 5); R = (st >> 1) * 16 + swz / 64; C = (st & 1) * 32 + (swz % 64) / 2; }
__host__ __device__ __forceinline__ int perm32(int rho) { const int n = rho >> 4, i = rho & 15; return 8 * (i >> 2) + 4 * n + (i & 3); }

struct Unit { int pm, pn, aux; };
struct Gemm { const bf16_t* A; const bf16_t* Bt; int lda, ldb, K; size_t a_aux, b_aux; };

struct Order {
    int nM, nN, per, nwg, G, c;
    __device__ __forceinline__ void init(int nM_, int nN_, int nAux_, int G_, int c_) { nM = nM_; nN = nN_; per = nM_ * nN_; nwg = per * nAux_; G = G_; c = c_; }
    __device__ __forceinline__ bool next(int i, Unit& u) const {
        const long L = (long)i * G + c; if (L >= nwg) return false;
        int wgid = (int)L; { const int q = nwg / NXCD, r = nwg % NXCD, xcd = wgid % NXCD, off = wgid / NXCD; wgid = (xcd < r ? xcd * (q + 1) : r * (q + 1) + (xcd - r) * q) + off; }
        u.aux = wgid / per; const int w = wgid - u.aux * per;
        const int nig = WGM * nN, gid = w / nig, fm = gid * WGM, gsz = (nM - fm) < WGM ? (nM - fm) : WGM;
        u.pm = fm + ((w % nig) % gsz); u.pn = (w % nig) / gsz; return true;
    }
};

__device__ __forceinline__ unsigned cvt_pk_bf16(float lo, float hi) { unsigned r; asm volatile("v_cvt_pk_bf16_f32 %0, %1, %2" : "=v"(r) : "v"(lo), "v"(hi)); return r; }
__device__ __forceinline__ u32x4 pack8(const f32x4 v0, const f32x4 v1) { u32x4 w; w.x = cvt_pk_bf16(v0[0], v0[1]); w.y = cvt_pk_bf16(v0[2], v0[3]); w.z = cvt_pk_bf16(v1[0], v1[1]); w.w = cvt_pk_bf16(v1[2], v1[3]); return w; }
__device__ __forceinline__ f32x2 gelu_tanh_pk(f32x2 x) {
    const f32x2 x2 = x * x, u = x * (x2 * 0.0356774081f + 0.7978845608f), t = u * (-2.885390082f);
    f32x2 e; e.x = __builtin_amdgcn_exp2f(t.x); e.y = __builtin_amdgcn_exp2f(t.y);
    const f32x2 d = e + 1.0f; f32x2 r; r.x = __builtin_amdgcn_rcpf(d.x); r.y = __builtin_amdgcn_rcpf(d.y);
    return x * r;
}
__device__ __forceinline__ f32x4 gelu4(const f32x4 v) { const f32x2 a = gelu_tanh_pk((f32x2){v[0], v[1]}), b = gelu_tanh_pk((f32x2){v[2], v[3]}); return (f32x4){a.x, a.y, b.x, b.y}; }
__device__ __forceinline__ f32x2 swiglu_pk(f32x2 g, f32x2 u) {
    const f32x2 t = g * (-1.4426950409f); f32x2 e; e.x = __builtin_amdgcn_exp2f(t.x); e.y = __builtin_amdgcn_exp2f(t.y);
    const f32x2 d = e + 1.0f; f32x2 r; r.x = __builtin_amdgcn_rcpf(d.x); r.y = __builtin_amdgcn_rcpf(d.y);
    return g * r * u;
}
__device__ __forceinline__ f32x4 swiglu4(const f32x4 g, const f32x4 u) { const f32x2 a = swiglu_pk((f32x2){g[0], g[1]}, (f32x2){u[0], u[1]}), b = swiglu_pk((f32x2){g[2], g[3]}, (f32x2){u[2], u[3]}); return (f32x4){a.x, a.y, b.x, b.y}; }

template <int RS_MODE> __device__ __forceinline__ float row_scale(const float* rs, int row) { const float v = rs[row]; return RS_MODE == 0 ? v : 1.0f / sqrtf(v * (1.0f / 4096.0f) + 1e-6f); }

template <int RS_MODE> struct EpiGelu {
    static constexpr bool PERM = true;
    bf16_t* O; int ldc; const float* rs;
    __device__ __forceinline__ void operator()(const f32x4 (&acc)[2][2][4][2], const Unit& u, int wr, int wc, int fr, int fq) const {
        const int row0 = u.pm * BM + wr * 64 + fr, col0 = u.pn * BM + wc * 32 + 8 * fq;
        float r[2][4];
#pragma unroll
        for (int ai = 0; ai < 2; ++ai)
#pragma unroll
            for (int m = 0; m < 4; ++m) r[ai][m] = row_scale<RS_MODE>(rs, row0 + ai * HALF + m * 16);
#pragma unroll
        for (int ai = 0; ai < 2; ++ai)
#pragma unroll
            for (int m = 0; m < 4; ++m) { bf16_t* rowp = O + (size_t)(row0 + ai * HALF + m * 16) * ldc + col0;
#pragma unroll
                for (int bj = 0; bj < 2; ++bj) *(u32x4*)(rowp + bj * HALF) = pack8(gelu4(acc[ai][bj][m][0] * r[ai][m]), gelu4(acc[ai][bj][m][1] * r[ai][m])); }
    }
};
template <int RS_MODE> struct EpiSwiglu {
    static constexpr bool PERM = true;
    bf16_t* O; int ldc; const float* rs;
    __device__ __forceinline__ void operator()(const f32x4 (&acc)[2][2][4][2], const Unit& u, int wr, int wc, int fr, int fq) const {
        const int row0 = u.pm * BM + wr * 64 + fr, col0 = u.pn * HALF + wc * 32 + 8 * fq;
        float r[2][4];
#pragma unroll
        for (int ai = 0; ai < 2; ++ai)
#pragma unroll
            for (int m = 0; m < 4; ++m) r[ai][m] = row_scale<RS_MODE>(rs, row0 + ai * HALF + m * 16);
#pragma unroll
        for (int ai = 0; ai < 2; ++ai)
#pragma unroll
            for (int m = 0; m < 4; ++m) { bf16_t* rowp = O + (size_t)(row0 + ai * HALF + m * 16) * ldc + col0; const float rr = r[ai][m];
                *(u32x4*)rowp = pack8(swiglu4(acc[ai][0][m][0] * rr, acc[ai][1][m][0] * rr), swiglu4(acc[ai][0][m][1] * rr, acc[ai][1][m][1] * rr)); }
    }
};
struct EpiScale {
    static constexpr bool PERM = true;
    bf16_t* O; int ldc; float scale; int aux_rows;
    __device__ __forceinline__ void operator()(const f32x4 (&acc)[2][2][4][2], const Unit& u, int wr, int wc, int fr, int fq) const {
        const int row0 = u.aux * aux_rows + u.pm * BM + wr * 64 + fr, col0 = u.pn * BM + wc * 32 + 8 * fq;
#pragma unroll
        for (int ai = 0; ai < 2; ++ai)
#pragma unroll
            for (int m = 0; m < 4; ++m) { bf16_t* rowp = O + (size_t)(row0 + ai * HALF + m * 16) * ldc + col0;
#pragma unroll
                for (int bj = 0; bj < 2; ++bj) *(u32x4*)(rowp + bj * HALF) = pack8(acc[ai][bj][m][0] * scale, acc[ai][bj][m][1] * scale); }
    }
};
template <bool WRITE_XN> struct EpiRes {
    static constexpr bool PERM = false;
    const float* base0; const float* base1; int split_pm; float* out; int ldc; bf16_t* xn; float* ss;
    __device__ __forceinline__ void operator()(const f32x4 (&acc)[2][2][4][2], const Unit& u, int wr, int wc, int fr, int fq) const {
        const float* bp = (u.pm < split_pm) ? base0 + (size_t)u.pm * BM * ldc : base1 + (size_t)(u.pm - split_pm) * BM * ldc;
        float* op = out + (size_t)u.pm * BM * ldc; bf16_t* xp = xn + (size_t)u.pm * BM * ldc;
        const int col0 = u.pn * BM + wc * 32 + 4 * fq;
#pragma unroll
        for (int ai = 0; ai < 2; ++ai) {
            f32x4 bs[4][2][2];
#pragma unroll
            for (int m = 0; m < 4; ++m) { const size_t off = (size_t)(ai * HALF + wr * 64 + m * 16 + fr) * ldc + col0;
#pragma unroll
                for (int bj = 0; bj < 2; ++bj)
#pragma unroll
                    for (int n = 0; n < 2; ++n) bs[m][bj][n] = *(const f32x4*)(bp + off + bj * HALF + n * 16); }
#pragma unroll
            for (int m = 0; m < 4; ++m) { const int rt = ai * HALF + wr * 64 + m * 16 + fr; const size_t off = (size_t)rt * ldc + col0; float s = 0.f;
#pragma unroll
                for (int bj = 0; bj < 2; ++bj)
#pragma unroll
                    for (int n = 0; n < 2; ++n) { const f32x4 o = bs[m][bj][n] + acc[ai][bj][m][n]; *(f32x4*)(op + off + bj * HALF + n * 16) = o;
                        s += (o[0] * o[0] + o[1] * o[1]) + (o[2] * o[2] + o[3] * o[3]);
                        if (WRITE_XN) { u32x2 w; w.x = cvt_pk_bf16(o[0], o[1]); w.y = cvt_pk_bf16(o[2], o[3]); *(u32x2*)(xp + off + bj * HALF + n * 16) = w; } }
                s += __shfl_xor(s, 16); s += __shfl_xor(s, 32);
                if (fq == 0) (void)__hip_atomic_fetch_add(ss + u.pm * BM + rt, s, __ATOMIC_RELAXED, __HIP_MEMORY_SCOPE_AGENT); }
            asm volatile("" ::: "memory");
        }
    }
};
struct EpiFourA {
    static constexpr bool PERM = true;
    bf16_t* T; int n_prompt, s_prompt, s_sample; const float* ss;
    __device__ __forceinline__ void operator()(const f32x4 (&acc)[2][2][4][2], const Unit& u, int wr, int wc, int fr, int fq) const {
        const int t0 = u.pn * BM; int S, tokbase;
        if (t0 < n_prompt) { S = s_prompt; tokbase = t0 & ~(s_prompt - 1); } else { S = s_sample; tokbase = n_prompt + ((t0 - n_prompt) & ~(s_sample - 1)); }
        const int s0 = t0 - tokbase + wc * 32 + 8 * fq, r0 = u.pm * BM + wr * 64 + fr;
        bf16_t* base = T + (size_t)tokbase * 8192 + s0;
        f32x4 rc[2][2];
#pragma unroll
        for (int bj = 0; bj < 2; ++bj)
#pragma unroll
            for (int n = 0; n < 2; ++n) { const f32x4 v = *(const f32x4*)(ss + tokbase + s0 + bj * HALF + 4 * n);
#pragma unroll
                for (int j = 0; j < 4; ++j) rc[bj][n][j] = 1.0f / sqrtf(v[j] * (1.0f / 4096.0f) + 1e-6f); }
#pragma unroll
        for (int ai = 0; ai < 2; ++ai)
#pragma unroll
            for (int m = 0; m < 4; ++m) { const int r = r0 + ai * HALF + m * 16, k2 = r & 511, cs = r >> 9;
                bf16_t* p = base + (size_t)(u.aux * 512 + k2) * (size_t)(2 * S) + (size_t)cs * S;
#pragma unroll
                for (int bj = 0; bj < 2; ++bj) *(u32x4*)(p + bj * HALF) = pack8(acc[ai][bj][m][0] * rc[bj][0], acc[ai][bj][m][1] * rc[bj][1]); }
    }
};

template <class Epi, bool ALIGN_EPI = true>
__device__ __forceinline__ void gemm_phase(PG8_LAS unsigned char* lds, const Gemm g, const Order& S, const Epi& E) {
    const int tid = threadIdx.x, wid = __builtin_amdgcn_readfirstlane(tid >> 6), lane = tid & 63, wr = wid >> 2, wc = wid & 3, fr = lane & 15, fq = lane >> 4;
    const int K = g.K, nt = K / BK;
    unsigned voffA[2], voffB[2];
#pragma unroll
    for (int i = 0; i < 2; ++i) { int R, C; stage_rc(tid * 16 + i * 8192, R, C); const int Rb = Epi::PERM ? ((R & ~31) + perm32(R & 31)) : R;
        voffA[i] = (unsigned)(R * g.lda + C) * 2u; voffB[i] = (unsigned)(Rb * g.ldb + C) * 2u; }
    const size_t kstep = (size_t)(BK * 2);
    const size_t hsA = (size_t)HALF * g.lda * 2, hsB = (size_t)HALF * g.ldb * 2;
    const unsigned ldsw = (unsigned)wid * 1024u;
    const int aoff = lds_byte(wr * 64 + fr, fq * 8), boff = lds_byte(wc * 32 + fr, fq * 8);
#define PG8_SA(b, h) (((b) * 2 + (h)) * HTB)
#define PG8_SB(b, h) ((4 + (b) * 2 + (h)) * HTB)
#define PG8_STAGE(bufoff, gbase, voff) do { _Pragma("unroll") for (int _i = 0; _i < 2; ++_i) \
        __builtin_amdgcn_global_load_lds((const unsigned*)((const char*)(gbase) + (voff)[_i]), (PG8_LAS unsigned*)(lds + (bufoff) + ldsw + _i * 8192), 16, 0, 0); } while (0)
#define PG8_LDA(dst, b, h) do { _Pragma("unroll") for (int m = 0; m < 4; ++m) _Pragma("unroll") for (int k = 0; k < 2; ++k) dst[m][k] = *(const PG8_LAS bf16x8*)(lds + PG8_SA(b, h) + aoff + m * 2048 + k * 1024); } while (0)
#define PG8_LDB(dst, b, h) do { _Pragma("unroll") for (int n = 0; n < 2; ++n) _Pragma("unroll") for (int k = 0; k < 2; ++k) dst[n][k] = *(const PG8_LAS bf16x8*)(lds + PG8_SB(b, h) + boff + n * 2048 + k * 1024); } while (0)
#define PG8_MMA(ai, bj, At, Bt) do { __builtin_amdgcn_s_setprio(1); _Pragma("unroll") for (int m = 0; m < 4; ++m) _Pragma("unroll") for (int n = 0; n < 2; ++n) _Pragma("unroll") for (int k = 0; k < 2; ++k) \
        acc[ai][bj][m][n] = __builtin_amdgcn_mfma_f32_16x16x32_bf16(Bt[n][k], At[m][k], acc[ai][bj][m][n], 0, 0, 0); __builtin_amdgcn_s_setprio(0); } while (0)
#define PG8_WAIT_V(n) asm volatile("s_waitcnt vmcnt(" #n ")" ::: "memory")
#define PG8_WAIT_L(n) asm volatile("s_waitcnt lgkmcnt(" #n ")" ::: "memory")
#define PG8_BAR __builtin_amdgcn_s_barrier()
#define PG8_SCHED __builtin_amdgcn_sched_barrier(0)
#define PG8_APTR(u) ((const char*)g.A + ((size_t)(u).pm * BM * g.lda + (size_t)(u).aux * g.a_aux) * 2)
#define PG8_BPTR(u) ((const char*)g.Bt + ((size_t)(u).pn * BM * g.ldb + (size_t)(u).aux * g.b_aux) * 2)
    Unit cur, nxt; int ui = 0;
    if (!S.next(0, cur)) return;
    f32x4 acc[2][2][4][2];
#pragma unroll
    for (int a = 0; a < 2; ++a)
#pragma unroll
        for (int b = 0; b < 2; ++b)
#pragma unroll
            for (int m = 0; m < 4; ++m)
#pragma unroll
                for (int n = 0; n < 2; ++n) acc[a][b][m][n] = (f32x4){0.f, 0.f, 0.f, 0.f};
    bf16x8 At[4][2], B0[2][2], B1[2][2];
    const char* cA = PG8_APTR(cur); const char* cB = PG8_BPTR(cur);
    PG8_STAGE(PG8_SB(0, 0), cB, voffB); PG8_STAGE(PG8_SB(0, 1), cB + hsB, voffB); PG8_STAGE(PG8_SA(0, 0), cA, voffA); PG8_STAGE(PG8_SA(0, 1), cA + hsA, voffA);
    if (wr == 1) PG8_BAR;
    PG8_WAIT_V(2); PG8_BAR;
    PG8_STAGE(PG8_SB(1, 0), cB + kstep, voffB); PG8_STAGE(PG8_SA(1, 0), cA + kstep, voffA); PG8_STAGE(PG8_SB(1, 1), cB + hsB + kstep, voffB);
    PG8_WAIT_V(6); PG8_BAR;
    for (;;) {
        const bool has_next = S.next(ui + 1, nxt);
        const char* nA = has_next ? PG8_APTR(nxt) : cA; const char* nB = has_next ? PG8_BPTR(nxt) : cB;
        for (int t = 0; t < nt; t += 2) {
            const bool last = (t == nt - 2);
            const char* a1 = cA + (size_t)(t + 1) * kstep;
            const char* a2 = last ? nA : cA + (size_t)(t + 2) * kstep; const char* b2 = last ? nB : cB + (size_t)(t + 2) * kstep;
            const char* a3 = a2 + kstep; const char* b3 = b2 + kstep;
            PG8_LDB(B0, 0, 0); PG8_LDB(B1, 0, 1); PG8_SCHED; PG8_LDA(At, 0, 0); PG8_STAGE(PG8_SA(1, 1), a1 + hsA, voffA);
            PG8_WAIT_V(8); PG8_WAIT_L(0); PG8_BAR; PG8_MMA(0, 0, At, B0); PG8_MMA(0, 1, At, B1); PG8_BAR; PG8_SCHED;
            PG8_LDA(At, 0, 1); PG8_STAGE(PG8_SB(0, 0), b2, voffB); PG8_STAGE(PG8_SB(0, 1), b2 + hsB, voffB); PG8_STAGE(PG8_SA(0, 0), a2, voffA);
            PG8_WAIT_V(8); PG8_WAIT_L(0); PG8_BAR; PG8_MMA(1, 0, At, B0); PG8_MMA(1, 1, At, B1); PG8_BAR; PG8_SCHED;
            PG8_LDB(B0, 1, 0); PG8_LDB(B1, 1, 1); PG8_SCHED; PG8_LDA(At, 1, 0); PG8_STAGE(PG8_SA(0, 1), a2 + hsA, voffA);
            PG8_WAIT_V(8); PG8_WAIT_L(0); PG8_BAR; PG8_MMA(0, 0, At, B0); PG8_MMA(0, 1, At, B1); PG8_BAR; PG8_SCHED;
            PG8_LDA(At, 1, 1); PG8_STAGE(PG8_SB(1, 0), b3, voffB); PG8_STAGE(PG8_SB(1, 1), b3 + hsB, voffB); PG8_STAGE(PG8_SA(1, 0), a3, voffA);
            PG8_WAIT_V(8); PG8_WAIT_L(0); PG8_BAR; PG8_MMA(1, 0, At, B0); PG8_MMA(1, 1, At, B1); PG8_BAR; PG8_SCHED;
        }
        if constexpr (ALIGN_EPI) { if (wr == 0) PG8_BAR; }
        E(acc, cur, wr, wc, fr, fq);
        if (!has_next) break;
#pragma unroll
        for (int a = 0; a < 2; ++a)
#pragma unroll
            for (int b = 0; b < 2; ++b)
#pragma unroll
                for (int m = 0; m < 4; ++m)
#pragma unroll
                    for (int n = 0; n < 2; ++n) acc[a][b][m][n] = (f32x4){0.f, 0.f, 0.f, 0.f};
        cur = nxt; cA = nA; cB = nB; ++ui;
        if constexpr (ALIGN_EPI) { if (wr == 1) PG8_BAR; }
    }
    PG8_WAIT_V(0);
    if constexpr (!ALIGN_EPI) { if (wr == 0) PG8_BAR; }
    PG8_BAR;
#undef PG8_SA
#undef PG8_SB
#undef PG8_STAGE
#undef PG8_LDA
#undef PG8_LDB
#undef PG8_MMA
#undef PG8_WAIT_V
#undef PG8_WAIT_L
#undef PG8_BAR
#undef PG8_SCHED
#undef PG8_APTR
#undef PG8_BPTR
}
}

constexpr int NWAVES = 8;
constexpr int DM = 4096, DFF = 11008, NB_P = 8, S_P = 2048, NB_S = 2, S_S = 4096;
constexpr int M_P = NB_P * S_P, M_S = NB_S * S_S, MT = M_P + M_S;
constexpr int NHEAD = 32, CHUNK = 128, HD = 128, NGRP = 8, GD = 512;
constexpr float EPS = 1e-6f;
constexpr int N_PHASES = 12;
constexpr int N_LAUNCHES = MK_N_LAUNCHES;
static_assert(N_LAUNCHES == 1 || N_LAUNCHES == N_PHASES, "MK_N_LAUNCHES must be 1 or 12");

constexpr size_t MiB = 1u << 20;
constexpr size_t WS_CTL = 0, CTL_ZERO_BYTES = 1 * MiB;
constexpr size_t WS_WIN = 1 * MiB;
constexpr size_t WS_WOA = WS_WIN + (size_t)2 * DM * DM * 2;
constexpr size_t WS_WOB = WS_WOA + (size_t)DM * DM * 2;
constexpr size_t WS_WGU = WS_WOB + (size_t)DM * DM * 2;
constexpr size_t WGU_BYTES = (size_t)2 * DFF * DM * 2;
constexpr size_t WS_WD = WS_WGU + 2 * WGU_BYTES;
constexpr size_t WD_BYTES = (size_t)DM * DFF * 2;
constexpr size_t WS_WSB = WS_WD + 2 * WD_BYTES;
constexpr size_t WS_D512 = WS_WSB + 1 * MiB;
constexpr size_t WS_ADP = WS_D512 + 8 * MiB;
constexpr size_t WS_ADS = WS_ADP + (size_t)S_P * 2 * S_P * 2;
constexpr size_t WS_XN = WS_ADS + (size_t)S_S * 2 * S_S * 2;
constexpr size_t WS_XN2 = WS_XN + (size_t)MT * DM * 2;
constexpr size_t WS_BIG = WS_XN2 + (size_t)MT * DM * 2;
constexpr size_t WS_END = WS_BIG + (size_t)MT * DFF * 2;
static_assert(WS_WSB % 256 == 0 && WS_XN % 256 == 0 && WS_BIG % 256 == 0, "alignment");
constexpr int CW_TMO = 0;
constexpr int CW_BAR = 4096;
constexpr int CW_R0 = 16384;
constexpr int CW_SS = CW_R0 + MT;
static_assert((size_t)(CW_SS + 4 * MT) * 4 <= CTL_ZERO_BYTES, "control words inside the memset region");

constexpr int RING_OFF = 0, RING_BYTES = 131072;
constexpr int LDSCTL_OFF = RING_BYTES, MISC_OFF = LDSCTL_OFF + 320;
constexpr int LDS_BYTES = 147456;

#define GAS __attribute__((address_space(1)))
#define LAS __attribute__((address_space(3)))
typedef unsigned short bf16;
typedef unsigned v4u __attribute__((ext_vector_type(4)));
typedef unsigned v2u __attribute__((ext_vector_type(2)));
typedef float f32x4 __attribute__((ext_vector_type(4)));
typedef short bf16x8 __attribute__((ext_vector_type(8)));
typedef GAS unsigned gu32;
#define RLX_AGENT __ATOMIC_RELAXED, __HIP_MEMORY_SCOPE_AGENT
__device__ __forceinline__ unsigned pk2(float lo, float hi) { return pg8::cvt_pk_bf16(lo, hi); }
__device__ __forceinline__ float bf_lo(unsigned w) { return __uint_as_float(w << 16); }
__device__ __forceinline__ float bf_hi(unsigned w) { return __uint_as_float(w & 0xffff0000u); }

#define XB_TMO      128
#define XB_XCNT(j)  (256  + 64 * (j))
#define XB_XSUB(j)  (1280 + 64 * (j))
#define XB_XGEN(j)  (2304 + 64 * (j))
#define XB_TOP      3328
#define XB_TOPGEN   3392
#define XCD_BAR_WORDS 3456
#define XB_SPIN_CAP (1u << 18)

__device__ __forceinline__ unsigned xb_ld(unsigned* p)              { return __hip_atomic_load(p, __ATOMIC_RELAXED, __HIP_MEMORY_SCOPE_AGENT); }
__device__ __forceinline__ unsigned xb_add(unsigned* p, unsigned v) { return __hip_atomic_fetch_add(p, v, __ATOMIC_RELAXED, __HIP_MEMORY_SCOPE_AGENT); }
__device__ __forceinline__ unsigned xb_xcc_id() { return (unsigned)__builtin_amdgcn_s_getreg((3 << 11) | 20) & 0xFu; }
#define XB_SPIN(cond, bar) do { unsigned _sp = 0; while (cond) { __builtin_amdgcn_s_sleep(1); \
    if ((++_sp & 255u) == 0u) { if (xb_ld(&(bar)[XB_TMO])) break; if (_sp > XB_SPIN_CAP) { atomicAdd(&(bar)[XB_TMO], 1u); break; } } } } while (0)

struct XcdBarrier {
    unsigned* bar; unsigned x;
    volatile LAS unsigned* st;
};
__device__ __forceinline__ XcdBarrier xcd_barrier_post(unsigned* bar, volatile LAS unsigned* st) {
    XcdBarrier b; b.bar = bar; b.x = xb_xcc_id(); b.st = st;
    if (threadIdx.x == 0) (void)xb_add(&bar[XB_XCNT(b.x)], 1u);
    return b;
}
__device__ __forceinline__ void xcd_barrier_complete(unsigned* bar, unsigned x, unsigned& nloc, unsigned& nx) {
    const unsigned G = gridDim.x * gridDim.y * gridDim.z;
    unsigned sum, cnt, mine, sp = 0u;
    for (;;) {
        sum = 0u; cnt = 0u; mine = 0u;
#pragma unroll
        for (unsigned j = 0; j < 16; ++j) { const unsigned c = xb_ld(&bar[XB_XCNT(j)]); sum += c; cnt += (c > 0u) ? 1u : 0u; mine = (j == x) ? c : mine; }
        if (sum == G) break;
        __builtin_amdgcn_s_sleep(1);
        if ((++sp & 255u) == 0u) { if (xb_ld(&bar[XB_TMO])) break; if (sp > XB_SPIN_CAP) { atomicAdd(&bar[XB_TMO], 1u); break; } }
    }
    nloc = mine > 0u ? mine : 1u; nx = cnt > 0u ? cnt : 1u;
}
__device__ __forceinline__ void xcd_barrier(const XcdBarrier& b) {
    asm volatile("s_waitcnt vmcnt(0)" ::: "memory");
    __syncthreads();
    if (threadIdx.x == 0) {
        unsigned* bar = b.bar;
        __builtin_amdgcn_s_waitcnt(0);
        unsigned nloc = b.st[0], nx = b.st[1];
        if (nloc == 0u) { xcd_barrier_complete(bar, b.x, nloc, nx); b.st[0] = nloc; b.st[1] = nx; }
        const unsigned old = xb_add(&bar[XB_XSUB(b.x)], 1u);
        const unsigned gen = old / nloc;
        if (old + 1u == (gen + 1u) * nloc) {
            __builtin_amdgcn_fence(__ATOMIC_RELEASE, "agent");
            asm volatile("s_waitcnt vmcnt(0)" ::: "memory");
            const unsigned og = xb_add(&bar[XB_TOP], 1u);
            const unsigned tg = og / nx;
            if (og + 1u == (tg + 1u) * nx) xb_add(&bar[XB_TOPGEN], 1u);
            else XB_SPIN(xb_ld(&bar[XB_TOPGEN]) == tg, bar);
            __builtin_amdgcn_fence(__ATOMIC_ACQUIRE, "agent");
            xb_add(&bar[XB_XGEN(b.x)], 1u);
            asm volatile("s_waitcnt vmcnt(0)" ::: "memory");
        } else {
            XB_SPIN(xb_ld(&bar[XB_XGEN(b.x)]) == gen, bar);
            __builtin_amdgcn_fence(__ATOMIC_ACQUIRE, "agent");
            asm volatile("s_waitcnt vmcnt(0)" ::: "memory");
        }
    }
    __syncthreads();
}

struct Args { const float* in[16]; float* out; unsigned char* ws; int ph_lo, ph_hi; };
struct Frame {
    LAS unsigned char* lds;
    int tid, lane, wave, vcu, G;
};
__device__ __forceinline__ float wave_sum(float v) {
#pragma unroll
    for (int o = 1; o < 64; o <<= 1) v += __shfl_xor(v, o);
    return v;
}

__device__ __forceinline__ void p0_transpose_item(const float* W, int K, int N, bf16* WT, int mode, const float* gain, LAS float* scr, int item, int lane) {
    const int nblk = N / 32, kb = item / nblk, nb = item - kb * nblk, k0 = 64 * kb, n0 = 32 * nb;
#pragma unroll 8
    for (int i = 0; i < 32; ++i) { const int kk = 2 * i + (lane >> 5); const float gk = gain ? gain[k0 + kk] : 1.0f; scr[kk * 33 + (lane & 31)] = W[(size_t)(k0 + kk) * N + n0 + (lane & 31)] * gk; }
    asm volatile("s_waitcnt lgkmcnt(0)" ::: "memory");
    const int c = lane & 7;
    const int drow0 = (mode == 0) ? n0 : ((n0 >> 7) * 256 + (n0 & 127) + (mode == 2 ? 128 : 0));
#pragma unroll
    for (int j = 0; j < 4; ++j) { const int n = (lane >> 3) + 8 * j; const LAS float* sp = scr + (8 * c) * 33 + n;
        v4u o; o.x = pk2(sp[0 * 33], sp[1 * 33]); o.y = pk2(sp[2 * 33], sp[3 * 33]); o.z = pk2(sp[4 * 33], sp[5 * 33]); o.w = pk2(sp[6 * 33], sp[7 * 33]);
        *(v4u*)(WT + (size_t)(drow0 + n) * K + k0 + 8 * c) = o; }
    asm volatile("s_waitcnt lgkmcnt(0)" ::: "memory");
}

__device__ __forceinline__ void p0_prologue(const Frame& F, const Args& a) {
    unsigned char* ws = a.ws;
    LAS float* scr = (LAS float*)(F.lds + RING_OFF + F.wave * 16384);
    const int gw = F.vcu * NWAVES + F.wave, NGW = F.G * NWAVES;
    constexpr int I_IN = (DM / 64) * (2 * DM / 32), I_O = (DM / 64) * (DM / 32), I_GU = (DM / 64) * (DFF / 32), I_D = (DFF / 64) * (DM / 32);
    constexpr int NITEMS = I_IN + 2 * I_O + 4 * I_GU + 2 * I_D;
    for (int it = gw; it < NITEMS; it += NGW) {
        int r = it;
        if (r < I_IN) { p0_transpose_item(a.in[3], DM, 2 * DM, (bf16*)(ws + WS_WIN), 0, a.in[2], scr, r, F.lane); continue; } r -= I_IN;
        if (r < I_O) { p0_transpose_item(a.in[8], DM, DM, (bf16*)(ws + WS_WOA), 0, nullptr, scr, r, F.lane); continue; } r -= I_O;
        if (r < I_O) { p0_transpose_item(a.in[10], DM, DM, (bf16*)(ws + WS_WOB), 0, nullptr, scr, r, F.lane); continue; } r -= I_O;
        if (r < 4 * I_GU) { const int q = r / I_GU, l = q >> 1, up = q & 1; r -= q * I_GU;
            p0_transpose_item(a.in[up ? 13 : 12] + (size_t)l * DM * DFF, DM, DFF, (bf16*)(ws + WS_WGU + (size_t)l * WGU_BYTES), 1 + up, a.in[11] + l * DM, scr, r, F.lane); continue; } r -= 4 * I_GU;
        { const int l = r / I_D; r -= l * I_D; p0_transpose_item(a.in[14] + (size_t)l * DFF * DM, DFF, DM, (bf16*)(ws + WS_WD + (size_t)l * WD_BYTES), 0, nullptr, scr, r, F.lane); }
    }
    const int gt = (F.vcu * NWAVES + F.wave) * 64 + F.lane, NGT = F.G * NWAVES * 64;
    for (int i = gt; i < NHEAD * CHUNK * CHUNK / 8; i += NGT) { const f32x4 x0 = ((const f32x4*)a.in[6])[2 * i], x1 = ((const f32x4*)a.in[6])[2 * i + 1];
        v4u o; o.x = pk2(x0.x, x0.y); o.y = pk2(x0.z, x0.w); o.z = pk2(x1.x, x1.y); o.w = pk2(x1.z, x1.w); ((v4u*)(ws + WS_WSB))[i] = o; }
    for (int i = gt; i < NGRP * 1024 * 512 / 8; i += NGT) { const int g = i >> 16, r = (i >> 6) & 1023, c0 = (i & 63) * 8, k2 = r & 511, cs = r >> 9; float v[8];
        const f32x4 g0 = *(const f32x4*)(a.in[9] + g * GD + c0), g1 = *(const f32x4*)(a.in[9] + g * GD + c0 + 4);
#pragma unroll
        for (int j = 0; j < 8; ++j) { const int idx = (k2 * (c0 + j)) & 511; float sn, cn; sincospif((float)idx * (2.0f / 512.0f), &sn, &cn); v[j] = (cs ? sn : cn) * (j < 4 ? g0[j & 3] : g1[j & 3]); }
        v4u o; o.x = pk2(v[0], v[1]); o.y = pk2(v[2], v[3]); o.z = pk2(v[4], v[5]); o.w = pk2(v[6], v[7]); ((v4u*)(ws + WS_D512))[i] = o; }
#pragma unroll
    for (int which = 0; which < 2; ++which) {
        const int S = which ? S_S : S_P, lg = which ? 12 : 11; bf16* AD = (bf16*)(ws + (which ? WS_ADS : WS_ADP)); const float inv = 2.0f / (float)S;
        for (int i = gt; i < S * S / 8; i += NGT) { const int k1 = i >> (lg - 3), s0 = (i & ((S >> 3) - 1)) * 8; float cv[8], sv[8];
#pragma unroll
            for (int j = 0; j < 8; ++j) { const int idx = (k1 * (s0 + j)) & (S - 1); float sn, cn; sincospif((float)idx * inv, &sn, &cn); cv[j] = cn; sv[j] = -sn; }
            v4u oc, os; oc.x = pk2(cv[0], cv[1]); oc.y = pk2(cv[2], cv[3]); oc.z = pk2(cv[4], cv[5]); oc.w = pk2(cv[6], cv[7]);
            os.x = pk2(sv[0], sv[1]); os.y = pk2(sv[2], sv[3]); os.z = pk2(sv[4], sv[5]); os.w = pk2(sv[6], sv[7]);
            *(v4u*)(AD + (size_t)k1 * 2 * S + s0) = oc; *(v4u*)(AD + (size_t)k1 * 2 * S + S + s0) = os; }
    }
    { bf16* XN = (bf16*)(ws + WS_XN); float* R0 = (float*)(ws + WS_CTL) + CW_R0;
      for (int m = gw; m < MT; m += NGW) {
        const float* xrow = (m < M_P) ? a.in[0] + (size_t)m * DM : a.in[1] + (size_t)(m - M_P) * DM;
        const f32x4* xr = (const f32x4*)xrow + F.lane; v2u* o = (v2u*)(XN + (size_t)m * DM) + F.lane; float sq = 0.f;
#pragma unroll
        for (int j = 0; j < 16; ++j) { const f32x4 v = xr[64 * j]; sq += (v.x * v.x + v.y * v.y) + (v.z * v.z + v.w * v.w); v2u w; w.x = pk2(v.x, v.y); w.y = pk2(v.z, v.w); o[64 * j] = w; }
        sq = wave_sum(sq);
        if (F.lane == 0) R0[m] = 1.0f / sqrtf(sq * (1.0f / DM) + EPS); } }
}

__device__ __forceinline__ void gate_phase(const Frame& F, const Args& a) {
    const bf16* Z = (const bf16*)(a.ws + WS_BIG); bf16* Gout = (bf16*)(a.ws + WS_XN2); const bf16* WSB = (const bf16*)(a.ws + WS_WSB);
    const float* ln_g = a.in[4]; const float* ln_b = a.in[5]; const float* b_s = a.in[7];
    LAS float* st = (LAS float*)(F.lds + RING_OFF);
    LAS bf16* Vt = (LAS bf16*)(F.lds + RING_OFF + 4096);
    constexpr int VP = 136;
    const int t = F.tid, lane = F.lane, w = F.wave, fr = lane & 15, fq = lane >> 4;
    for (int unit = F.vcu; unit < (MT / CHUNK) * 4; unit += F.G) {
        const int chunk = unit >> 2, hg = unit & 3, r0 = chunk * CHUNK;
        for (int rr = 0; rr < 16; ++rr) { const int q = 16 * w + rr;
            const v4u* vr = (const v4u*)(Z + (size_t)(r0 + q) * (2 * DM) + DM) + lane; v4u raw[8]; float s = 0.f;
#pragma unroll
            for (int j = 0; j < 8; ++j) { raw[j] = vr[64 * j]; s += (bf_lo(raw[j].x) + bf_hi(raw[j].x)) + (bf_lo(raw[j].y) + bf_hi(raw[j].y)) + (bf_lo(raw[j].z) + bf_hi(raw[j].z)) + (bf_lo(raw[j].w) + bf_hi(raw[j].w)); }
            const float mean = wave_sum(s) * (1.0f / DM); float s2 = 0.f;
#pragma unroll
            for (int j = 0; j < 8; ++j) {
#pragma unroll
                for (int e = 0; e < 4; ++e) { const float d0 = bf_lo(raw[j][e]) - mean, d1 = bf_hi(raw[j][e]) - mean; s2 += d0 * d0 + d1 * d1; } }
            const float rstd = 1.0f / sqrtf(wave_sum(s2) * (1.0f / DM) + EPS);
            if (lane == 0) { st[2 * q] = mean; st[2 * q + 1] = rstd; } }
        __syncthreads();
        for (int hh = 0; hh < 8; ++hh) { const int h = hg * 8 + hh;
            { const int q = t >> 2, cs = (t & 3) * 32; const float mean = st[2 * q], rstd = st[2 * q + 1];
              const v4u* src = (const v4u*)(Z + (size_t)(r0 + q) * (2 * DM) + DM + h * HD + cs);
              const f32x4* gp = (const f32x4*)(ln_g + h * HD + cs); const f32x4* bp = (const f32x4*)(ln_b + h * HD + cs);
#pragma unroll
              for (int i = 0; i < 4; ++i) { const v4u raw = src[i]; const f32x4 g0 = gp[2 * i], g1 = gp[2 * i + 1], b0 = bp[2 * i], b1 = bp[2 * i + 1];
                  float y[8];
                  y[0] = (bf_lo(raw.x) - mean) * rstd * g0.x + b0.x; y[1] = (bf_hi(raw.x) - mean) * rstd * g0.y + b0.y; y[2] = (bf_lo(raw.y) - mean) * rstd * g0.z + b0.z; y[3] = (bf_hi(raw.y) - mean) * rstd * g0.w + b0.w;
                  y[4] = (bf_lo(raw.z) - mean) * rstd * g1.x + b1.x; y[5] = (bf_hi(raw.z) - mean) * rstd * g1.y + b1.y; y[6] = (bf_lo(raw.w) - mean) * rstd * g1.z + b1.z; y[7] = (bf_hi(raw.w) - mean) * rstd * g1.w + b1.w;
#pragma unroll
                  for (int e = 0; e < 8; e += 2) { const unsigned pk = pk2(y[e], y[e + 1]); Vt[(cs + 8 * i + e) * VP + q] = (bf16)(pk & 0xffffu); Vt[(cs + 8 * i + e + 1) * VP + q] = (bf16)(pk >> 16); } } }
            __syncthreads();
            const int p = 16 * w + fr;
            bf16x8 af[4];
#pragma unroll
            for (int ks = 0; ks < 4; ++ks) af[ks] = *(const bf16x8*)(WSB + ((size_t)h * CHUNK + p) * CHUNK + 32 * ks + 8 * fq);
            const float bias = b_s[h * CHUNK + p];
#pragma unroll
            for (int ct = 0; ct < 8; ++ct) { f32x4 acc = (f32x4){0.f, 0.f, 0.f, 0.f};
#pragma unroll
                for (int ks = 0; ks < 4; ++ks) { const bf16x8 bfr = *(const LAS bf16x8*)(Vt + (16 * ct + fr) * VP + 32 * ks + 8 * fq); acc = __builtin_amdgcn_mfma_f32_16x16x32_bf16(bfr, af[ks], acc, 0, 0, 0); }
                const int c = 16 * ct + 4 * fq;
                const v2u uu = *(const v2u*)(Z + (size_t)(r0 + p) * (2 * DM) + h * HD + c);
                v2u o; o.x = pk2(bf_lo(uu.x) * (acc[0] + bias), bf_hi(uu.x) * (acc[1] + bias)); o.y = pk2(bf_lo(uu.y) * (acc[2] + bias), bf_hi(uu.y) * (acc[3] + bias));
                *(v2u*)(Gout + (size_t)(r0 + p) * DM + h * HD + c) = o; }
            __syncthreads();
        }
    }
}

__global__ void __launch_bounds__(NWAVES * 64, 2) mega_fwd(Args args) {
    extern __shared__ __attribute__((aligned(16))) unsigned char lds_raw[];
    Frame F;
    F.lds = (LAS unsigned char*)lds_raw;
    F.tid = threadIdx.x; F.lane = F.tid & 63; F.wave = __builtin_amdgcn_readfirstlane(F.tid >> 6);
    F.G = gridDim.x; { const int bx = blockIdx.x; F.vcu = (F.G % 8 == 0) ? (bx % 8) * (F.G / 8) + bx / 8 : bx; }
    unsigned char* ws = args.ws;
    gu32* ctl = (gu32*)(ws + WS_CTL);
    volatile LAS unsigned* MISC = (volatile LAS unsigned*)(F.lds + MISC_OFF);
    for (int u = F.tid; u < (LDS_BYTES - LDSCTL_OFF) / 4; u += NWAVES * 64) ((LAS unsigned*)(F.lds + LDSCTL_OFF))[u] = 0u;
    __syncthreads();
    XcdBarrier bar; bar.bar = (unsigned*)(ctl + CW_BAR); bar.x = 0; bar.st = nullptr;
    if (N_LAUNCHES == 1) bar = xcd_barrier_post((unsigned*)(ctl + CW_BAR), MISC + 8);
    const int lo = args.ph_lo, hi = args.ph_hi;
#define IN(k) (lo <= (k) && (k) < hi)
#define SEAM(k) do { if (IN(k) && IN((k) + 1)) xcd_barrier(bar); } while (0)
    LAS unsigned char* ring = F.lds + RING_OFF;
    const int bx = (int)blockIdx.x;
    bf16* XN = (bf16*)(ws + WS_XN); bf16* XN2 = (bf16*)(ws + WS_XN2); bf16* BIG = (bf16*)(ws + WS_BIG);
    const float* xp = args.in[0]; const float* xs = args.in[1];
    float* R0 = (float*)(ws + WS_CTL) + CW_R0; float* SS = (float*)(ws + WS_CTL) + CW_SS;
    typedef pg8::EpiRes<true> EpiResX; typedef pg8::EpiRes<false> EpiResL;

    if (IN(0)) { p0_prologue(F, args); } SEAM(0);
    if (IN(1)) { pg8::Gemm g{XN, (const bf16*)(ws + WS_WIN), DM, DM, DM, 0, 0}; pg8::Order S; S.init(MT / 256, 2 * DM / 256, 1, F.G, bx);
        pg8::EpiGelu<0> E{BIG, 2 * DM, R0}; pg8::gemm_phase<pg8::EpiGelu<0>>(ring, g, S, E); } SEAM(1);
    if (IN(2)) { gate_phase(F, args); } SEAM(2);
    if (IN(3)) { pg8::Gemm g{XN2, (const bf16*)(ws + WS_WOA), DM, DM, DM, 0, 0}; pg8::Order S; S.init(MT / 256, DM / 256, 1, F.G, bx);
        EpiResX E{xp, xs, M_P / 256, args.out, DM, XN, SS}; pg8::gemm_phase<EpiResX>(ring, g, S, E); } SEAM(3);
    if (IN(4)) { pg8::Gemm g{XN, (const bf16*)(ws + WS_WGU), DM, DM, DM, 0, 0}; pg8::Order S; S.init(MT / 256, 2 * DFF / 256, 1, F.G, bx);
        pg8::EpiSwiglu<1> E{BIG, DFF, SS}; pg8::gemm_phase<pg8::EpiSwiglu<1>>(ring, g, S, E); } SEAM(4);
    if (IN(5)) { pg8::Gemm g{BIG, (const bf16*)(ws + WS_WD), DFF, DFF, DFF, 0, 0}; pg8::Order S; S.init(MT / 256, DM / 256, 1, F.G, bx);
        EpiResX E{args.out, args.out, 1 << 30, args.out, DM, XN, SS + MT}; pg8::gemm_phase<EpiResX>(ring, g, S, E); } SEAM(5);
    if (IN(6)) { pg8::Gemm g{(const bf16*)(ws + WS_D512), XN, GD, DM, GD, (size_t)1024 * GD, (size_t)GD}; pg8::Order S; S.init(1024 / 256, MT / 256, NGRP, F.G, bx);
        pg8::EpiFourA E{BIG, M_P, S_P, S_S, SS + MT}; pg8::gemm_phase<pg8::EpiFourA>(ring, g, S, E); } SEAM(6);
    if (IN(7)) {
        { pg8::Gemm g{(const bf16*)(ws + WS_ADP), BIG, 2 * S_P, 2 * S_P, 2 * S_P, 0, (size_t)S_P * 8192}; pg8::Order S; S.init(S_P / 256, DM / 256, NB_P, F.G, bx);
          pg8::EpiScale E{XN2, DM, 0.0009765625f  , S_P}; pg8::gemm_phase<pg8::EpiScale>(ring, g, S, E); }
        { pg8::Gemm g{(const bf16*)(ws + WS_ADS), BIG + (size_t)M_P * 8192, 2 * S_S, 2 * S_S, 2 * S_S, 0, (size_t)S_S * 8192}; pg8::Order S; S.init(S_S / 256, DM / 256, NB_S, F.G, bx);
          pg8::EpiScale E{XN2 + (size_t)M_P * DM, DM, 0.00069053396600248784f  , S_S}; pg8::gemm_phase<pg8::EpiScale>(ring, g, S, E); }
    } SEAM(7);
    if (IN(8)) { pg8::Gemm g{XN2, (const bf16*)(ws + WS_WOB), DM, DM, DM, 0, 0}; pg8::Order S; S.init(MT / 256, DM / 256, 1, F.G, bx);
        EpiResX E{args.out, args.out, 1 << 30, args.out, DM, XN, SS + 2 * MT}; pg8::gemm_phase<EpiResX>(ring, g, S, E); } SEAM(8);
    if (IN(9)) { pg8::Gemm g{XN, (const bf16*)(ws + WS_WGU + WGU_BYTES), DM, DM, DM, 0, 0}; pg8::Order S; S.init(MT / 256, 2 * DFF / 256, 1, F.G, bx);
        pg8::EpiSwiglu<1> E{BIG, DFF, SS + 2 * MT}; pg8::gemm_phase<pg8::EpiSwiglu<1>>(ring, g, S, E); } SEAM(9);
    if (IN(10)) { pg8::Gemm g{BIG, (const bf16*)(ws + WS_WD + WD_BYTES), DFF, DFF, DFF, 0, 0}; pg8::Order S; S.init(MT / 256, DM / 256, 1, F.G, bx);
        EpiResL E{args.out, args.out, 1 << 30, args.out, DM, nullptr, SS + 3 * MT}; pg8::gemm_phase<EpiResL>(ring, g, S, E); } SEAM(10);
    if (IN(11)) {
        const bool bad = (N_LAUNCHES == 1) && __hip_atomic_load((unsigned*)(ctl + CW_BAR) + XB_TMO, RLX_AGENT) != 0u;
        const int gw = F.vcu * NWAVES + F.wave, NGW = F.G * NWAVES; const f32x4* gr = (const f32x4*)args.in[15] + F.lane;
        for (int m = gw; m < MT; m += NGW) { f32x4* o = (f32x4*)(args.out + (size_t)m * DM) + F.lane;
            float r = 1.0f / sqrtf(SS[3 * MT + m] * (1.0f / DM) + EPS); if (bad) r = __builtin_nanf("");
#pragma unroll
            for (int j = 0; j < 16; ++j) o[64 * j] = o[64 * j] * r * gr[64 * j]; }
    }
#undef IN
#undef SEAM
}

extern "C" void kernel_launch(void* const* d_in, const int* in_sizes, int n_in, void* d_out, int out_size, void* d_ws, size_t ws_size, hipStream_t stream) {
    static int grid = 0;
    if (grid == 0) {
        if (n_in != 16 || in_sizes[0] != M_P * DM || in_sizes[1] != M_S * DM || out_size != MT * DM || ws_size < WS_END) {
            fprintf(stderr, "kernel_launch: unexpected shapes (n_in %d, out %d, ws %zu, need %zu); nothing launched\n", n_in, out_size, ws_size, (size_t)WS_END); grid = -1; return; }
        int dev = 0, cus = 0, per_cu = 0;
        if (hipGetDevice(&dev) != hipSuccess || hipDeviceGetAttribute(&cus, hipDeviceAttributeMultiprocessorCount, dev) != hipSuccess) { grid = -1; return; }
        if (hipFuncSetAttribute((const void*)mega_fwd, hipFuncAttributeMaxDynamicSharedMemorySize, LDS_BYTES) != hipSuccess) { fprintf(stderr, "kernel_launch: hipFuncSetAttribute failed\n"); grid = -1; return; }
        if (hipOccupancyMaxActiveBlocksPerMultiprocessor(&per_cu, (const void*)mega_fwd, NWAVES * 64, LDS_BYTES) != hipSuccess || per_cu < 1)
            fprintf(stderr, "kernel_launch: note: occupancy query reports %d workgroups per CU\n", per_cu);
        (void)hipGetLastError();
        grid = cus;
    }
    if (grid < 0) return;
    if (hipMemsetAsync((char*)d_ws + WS_CTL, 0, CTL_ZERO_BYTES, stream) != hipSuccess) return;
    Args a{};
    for (int i = 0; i < 16; ++i) a.in[i] = (const float*)d_in[i];
    a.out = (float*)d_out; a.ws = (unsigned char*)d_ws;
    for (int li = 0; li < N_LAUNCHES; ++li) {
        a.ph_lo = (N_LAUNCHES == 1) ? 0 : li; a.ph_hi = (N_LAUNCHES == 1) ? N_PHASES : li + 1;
        hipLaunchKernelGGL(mega_fwd, dim3(grid), dim3(NWAVES * 64), LDS_BYTES, stream, a);
        const hipError_t le = hipPeekAtLastError();
        if (le != hipSuccess) { fprintf(stderr, "kernel_launch: launch %d failed: %s\n", li, hipGetErrorName(le)); break; }
    }
}
```

```cpp
#include <hip/hip_runtime.h>
#include <cstdio>
#include <cstdint>

#ifndef MK_N_LAUNCHES
#define MK_N_LAUNCHES 1
#endif

namespace pg8 {
#define PG8_LAS __attribute__((address_space(3)))
typedef unsigned short bf16_t;
typedef short bf16x8 __attribute__((ext_vector_type(8)));
typedef float f32x4 __attribute__((ext_vector_type(4)));
typedef float f32x2 __attribute__((ext_vector_type(2)));
typedef unsigned u32x4 __attribute__((ext_vector_type(4)));
constexpr int BM = 256, BK = 64, HALF = 128, HTB = HALF * BK * 2  , STAGE_BYTES = 8 * HTB, NXCD = 8, WGM = 8;

__host__ __device__ __forceinline__ int lds_byte(int r, int c) { const int st = (r >> 4) * 2 + (c >> 5), rr = r & 15, cc = c & 31, ob = rr * 64 + cc * 2; return st * 1024 + (ob ^ (((ob >> 9) & 1) << 5)); }
__host__ __device__ __forceinline__ void stage_rc(int b, int& R, int& C) { const int st = b / 1024, sb = b % 1024, swz = sb ^ (((sb >> 9) & 1) << 5); R = (st >> 1) * 16 + swz / 64; C = (st & 1) * 32 + (swz % 64) / 2; }
__host__ __device__ __forceinline__ int perm32(int rho) { const int n = rho >> 4, i = rho & 15; return 8 * (i >> 2) + 4 * n + (i & 3); }

struct Unit { int pm, pn, aux; };
struct Gemm { const bf16_t* A; const bf16_t* Bt; int lda, ldb, K; size_t a_aux, b_aux; size_t a_tile, b_tile; int ksA, ksB; };

struct Order {
    int nM, nN, per, nwg, G, c;
    __device__ __forceinline__ void init(int nM_, int nN_, int nAux_, int G_, int c_) { nM = nM_; nN = nN_; per = nM_ * nN_; nwg = per * nAux_; G = G_; c = c_; }
    __device__ __forceinline__ bool next(int i, Unit& u) const {
        const long L = (long)i * G + c; if (L >= nwg) return false;
        int wgid = (int)L; { const int q = nwg / NXCD, r = nwg % NXCD, xcd = wgid % NXCD, off = wgid / NXCD; wgid = (xcd < r ? xcd * (q + 1) : r * (q + 1) + (xcd - r) * q) + off; }
        u.aux = wgid / per; const int w = wgid - u.aux * per;
        const int nig = WGM * nN, gid = w / nig, fm = gid * WGM, gsz = (nM - fm) < WGM ? (nM - fm) : WGM;
        u.pm = fm + ((w % nig) % gsz); u.pn = (w % nig) / gsz; return true;
    }
};

__device__ __forceinline__ unsigned cvt_pk_bf16(float lo, float hi) { unsigned r; asm volatile("v_cvt_pk_bf16_f32 %0, %1, %2" : "=v"(r) : "v"(lo), "v"(hi)); return r; }
__device__ __forceinline__ u32x4 pack8(const f32x4 v0, const f32x4 v1) { u32x4 w; w.x = cvt_pk_bf16(v0[0], v0[1]); w.y = cvt_pk_bf16(v0[2], v0[3]); w.z = cvt_pk_bf16(v1[0], v1[1]); w.w = cvt_pk_bf16(v1[2], v1[3]); return w; }
__device__ __forceinline__ f32x2 gelu_tanh_pk(f32x2 x) {
    const f32x2 x2 = x * x, u = x * (x2 * 0.0356774081f + 0.7978845608f), t = u * (-2.885390082f);
    f32x2 e; e.x = __builtin_amdgcn_exp2f(t.x); e.y = __builtin_amdgcn_exp2f(t.y);
    const f32x2 d = e + 1.0f; f32x2 r; r.x = __builtin_amdgcn_rcpf(d.x); r.y = __builtin_amdgcn_rcpf(d.y);
    return x * r;
}
__device__ __forceinline__ f32x4 gelu4(const f32x4 v) { const f32x2 a = gelu_tanh_pk((f32x2){v[0], v[1]}), b = gelu_tanh_pk((f32x2){v[2], v[3]}); return (f32x4){a.x, a.y, b.x, b.y}; }
__device__ __forceinline__ f32x2 swiglu_pk(f32x2 g, f32x2 u) {
    const f32x2 t = g * (-1.4426950409f); f32x2 e; e.x = __builtin_amdgcn_exp2f(t.x); e.y = __builtin_amdgcn_exp2f(t.y);
    const f32x2 d = e + 1.0f; f32x2 r; r.x = __builtin_amdgcn_rcpf(d.x); r.y = __builtin_amdgcn_rcpf(d.y);
    return g * r * u;
}
__device__ __forceinline__ f32x4 swiglu4(const f32x4 g, const f32x4 u) { const f32x2 a = swiglu_pk((f32x2){g[0], g[1]}, (f32x2){u[0], u[1]}), b = swiglu_pk((f32x2){g[2], g[3]}, (f32x2){u[2], u[3]}); return (f32x4){a.x, a.y, b.x, b.y}; }

struct EpiGelu {
    static constexpr bool PERM = true;
    bf16_t* O; int ldc;
    __device__ __forceinline__ void operator()(const f32x4 (&acc)[2][2][4][2], const Unit& u, int wr, int wc, int fr, int fq) const {
        const int row0 = u.pm * BM + wr * 64 + fr, col0 = u.pn * BM + wc * 32 + 8 * fq;
#pragma unroll
        for (int ai = 0; ai < 2; ++ai)
#pragma unroll
            for (int m = 0; m < 4; ++m) { bf16_t* rowp = O + (size_t)(row0 + ai * HALF + m * 16) * ldc + col0;
#pragma unroll
                for (int bj = 0; bj < 2; ++bj) *(u32x4*)(rowp + bj * HALF) = pack8(gelu4(acc[ai][bj][m][0]), gelu4(acc[ai][bj][m][1])); }
    }
};
struct EpiSwiglu {
    static constexpr bool PERM = true;
    bf16_t* O; int ldc;
    __device__ __forceinline__ void operator()(const f32x4 (&acc)[2][2][4][2], const Unit& u, int wr, int wc, int fr, int fq) const {
        const int row0 = u.pm * BM + wr * 64 + fr, col0 = u.pn * HALF + wc * 32 + 8 * fq;
#pragma unroll
        for (int ai = 0; ai < 2; ++ai)
#pragma unroll
            for (int m = 0; m < 4; ++m) { bf16_t* rowp = O + (size_t)(row0 + ai * HALF + m * 16) * ldc + col0;
                *(u32x4*)rowp = pack8(swiglu4(acc[ai][0][m][0], acc[ai][1][m][0]), swiglu4(acc[ai][0][m][1], acc[ai][1][m][1])); }
    }
};
struct EpiScale {
    static constexpr bool PERM = true;
    bf16_t* O; int ldc; float scale; int aux_rows;
    __device__ __forceinline__ void operator()(const f32x4 (&acc)[2][2][4][2], const Unit& u, int wr, int wc, int fr, int fq) const {
        const int row0 = u.aux * aux_rows + u.pm * BM + wr * 64 + fr, col0 = u.pn * BM + wc * 32 + 8 * fq;
#pragma unroll
        for (int ai = 0; ai < 2; ++ai)
#pragma unroll
            for (int m = 0; m < 4; ++m) { bf16_t* rowp = O + (size_t)(row0 + ai * HALF + m * 16) * ldc + col0;
#pragma unroll
                for (int bj = 0; bj < 2; ++bj) *(u32x4*)(rowp + bj * HALF) = pack8(acc[ai][bj][m][0] * scale, acc[ai][bj][m][1] * scale); }
    }
};
struct EpiRes {
    static constexpr bool PERM = false;
    const float* base0; const float* base1; int split_pm; float* out; int ldc;
    __device__ __forceinline__ void operator()(const f32x4 (&acc)[2][2][4][2], const Unit& u, int wr, int wc, int fr, int fq) const {
        const float* bp = (u.pm < split_pm) ? base0 + (size_t)u.pm * BM * ldc : base1 + (size_t)(u.pm - split_pm) * BM * ldc;
        float* op = out + (size_t)u.pm * BM * ldc;
        const int col0 = u.pn * BM + wc * 32 + 4 * fq;
#pragma unroll
        for (int ai = 0; ai < 2; ++ai)
#pragma unroll
            for (int m = 0; m < 4; ++m) { const size_t off = (size_t)(ai * HALF + wr * 64 + m * 16 + fr) * ldc + col0;
#pragma unroll
                for (int bj = 0; bj < 2; ++bj)
#pragma unroll
                    for (int n = 0; n < 2; ++n) { const f32x4 bs = *(const f32x4*)(bp + off + bj * HALF + n * 16); *(f32x4*)(op + off + bj * HALF + n * 16) = bs + acc[ai][bj][m][n]; }
                asm volatile("" ::: "memory"); }
    }
};
struct FoldGeom { int ntp, tpp, tps, kpp, kps, nbp; };
struct OrderFour {
    int ntile, nwg, G, c; FoldGeom fg;
    __device__ __forceinline__ void init(int ntile_, int ngrp, int G_, int c_, FoldGeom fg_) { ntile = ntile_; nwg = ntile_ * 2 * ngrp; G = G_; c = c_; fg = fg_; }
    __device__ __forceinline__ bool next(int i, Unit& u) const {
        const long L = (long)i * G + c; if (L >= nwg) return false;
        int wgid = (int)L; { const int q = nwg / NXCD, r = nwg % NXCD, xcd = wgid % NXCD, off = wgid / NXCD; wgid = (xcd < r ? xcd * (q + 1) : r * (q + 1) + (xcd - r) * q) + off; }
        const int per = ntile * 2; u.aux = wgid / per; const int w = wgid - u.aux * per, ft = w >> 1;
        const bool ho = (ft < fg.ntp) ? ((ft % fg.tpp) >= (fg.tpp + 1) / 2) : (((ft - fg.ntp) % fg.tps) >= (fg.tps + 1) / 2);
        u.pm = (w & 1) + (ho ? 2 : 0); u.pn = ft; return true;
    }
};
struct EpiFourA {
    static constexpr bool PERM = true;
    bf16_t* T; FoldGeom fg;
    __device__ __forceinline__ void operator()(const f32x4 (&acc)[2][2][4][2], const Unit& u, int wr, int wc, int fr, int fq) const {
        const int ft = u.pn; int KP, tt; size_t tb;
        if (ft < fg.ntp) { const int b = ft / fg.tpp; tt = ft - b * fg.tpp; KP = fg.kpp; tb = (size_t)b * 4096 * fg.kpp; }
        else { const int b = (ft - fg.ntp) / fg.tps; tt = (ft - fg.ntp) - b * fg.tps; KP = fg.kps; tb = (size_t)fg.nbp * 4096 * fg.kpp + (size_t)b * 4096 * fg.kps; }
        const int j0 = tt * BM + wc * 32 + 8 * fq, r0 = u.pm * BM + wr * 64 + fr;
        bf16_t* base = T + tb + j0;
#pragma unroll
        for (int ai = 0; ai < 2; ++ai)
#pragma unroll
            for (int m = 0; m < 4; ++m) { const int k2 = (r0 + ai * HALF + m * 16) & 511;
                bf16_t* p = base + (size_t)(u.aux * 512 + k2) * (size_t)KP;
#pragma unroll
                for (int bj = 0; bj < 2; ++bj) *(u32x4*)(p + bj * HALF) = pack8(acc[ai][bj][m][0], acc[ai][bj][m][1]); }
    }
};

template <class Epi, class Sched = Order, bool ALIGN_EPI = true>
__device__ __forceinline__ void gemm_phase(PG8_LAS unsigned char* lds, const Gemm g, const Sched& S, const Epi& E) {
    const int tid = threadIdx.x, wid = __builtin_amdgcn_readfirstlane(tid >> 6), lane = tid & 63, wr = wid >> 2, wc = wid & 3, fr = lane & 15, fq = lane >> 4;
    const int K = g.K, nt = K / BK;
    unsigned voffA[2], voffB[2];
#pragma unroll
    for (int i = 0; i < 2; ++i) { int R, C; stage_rc(tid * 16 + i * 8192, R, C); const int Rb = Epi::PERM ? ((R & ~31) + perm32(R & 31)) : R;
        voffA[i] = (unsigned)(R * g.lda + C) * 2u; voffB[i] = (unsigned)(Rb * g.ldb + C) * 2u; }
    const size_t ksA = (size_t)g.ksA, ksB = (size_t)g.ksB;
    const size_t hsA = (size_t)HALF * g.lda * 2, hsB = (size_t)HALF * g.ldb * 2;
    const unsigned ldsw = (unsigned)wid * 1024u;
    const int aoff = lds_byte(wr * 64 + fr, fq * 8), boff = lds_byte(wc * 32 + fr, fq * 8);
#define PG8_SA(b, h) (((b) * 2 + (h)) * HTB)
#define PG8_SB(b, h) ((4 + (b) * 2 + (h)) * HTB)
#define PG8_STAGE(bufoff, gbase, voff) do { _Pragma("unroll") for (int _i = 0; _i < 2; ++_i) \
        __builtin_amdgcn_global_load_lds((const unsigned*)((const char*)(gbase) + (voff)[_i]), (PG8_LAS unsigned*)(lds + (bufoff) + ldsw + _i * 8192), 16, 0, 0); } while (0)
#define PG8_LDA(dst, b, h) do { _Pragma("unroll") for (int m = 0; m < 4; ++m) _Pragma("unroll") for (int k = 0; k < 2; ++k) dst[m][k] = *(const PG8_LAS bf16x8*)(lds + PG8_SA(b, h) + aoff + m * 2048 + k * 1024); } while (0)
#define PG8_LDB(dst, b, h) do { _Pragma("unroll") for (int n = 0; n < 2; ++n) _Pragma("unroll") for (int k = 0; k < 2; ++k) dst[n][k] = *(const PG8_LAS bf16x8*)(lds + PG8_SB(b, h) + boff + n * 2048 + k * 1024); } while (0)
#define PG8_MMA(ai, bj, At, Bt) do { __builtin_amdgcn_s_setprio(1); _Pragma("unroll") for (int m = 0; m < 4; ++m) _Pragma("unroll") for (int n = 0; n < 2; ++n) _Pragma("unroll") for (int k = 0; k < 2; ++k) \
        acc[ai][bj][m][n] = __builtin_amdgcn_mfma_f32_16x16x32_bf16(Bt[n][k], At[m][k], acc[ai][bj][m][n], 0, 0, 0); __builtin_amdgcn_s_setprio(0); } while (0)
#define PG8_WAIT_V(n) asm volatile("s_waitcnt vmcnt(" #n ")" ::: "memory")
#define PG8_WAIT_L(n) asm volatile("s_waitcnt lgkmcnt(" #n ")" ::: "memory")
#define PG8_BAR __builtin_amdgcn_s_barrier()
#define PG8_SCHED __builtin_amdgcn_sched_barrier(0)
#define PG8_APTR(u) ((const char*)g.A + ((size_t)(u).pm * g.a_tile + (size_t)(u).aux * g.a_aux) * 2)
#define PG8_BPTR(u) ((const char*)g.Bt + ((size_t)(u).pn * g.b_tile + (size_t)(u).aux * g.b_aux) * 2)
    Unit cur, nxt; int ui = 0;
    if (!S.next(0, cur)) return;
    f32x4 acc[2][2][4][2];
#pragma unroll
    for (int a = 0; a < 2; ++a)
#pragma unroll
        for (int b = 0; b < 2; ++b)
#pragma unroll
            for (int m = 0; m < 4; ++m)
#pragma unroll
                for (int n = 0; n < 2; ++n) acc[a][b][m][n] = (f32x4){0.f, 0.f, 0.f, 0.f};
    bf16x8 At[4][2], B0[2][2], B1[2][2];
    const char* cA = PG8_APTR(cur); const char* cB = PG8_BPTR(cur);
    PG8_STAGE(PG8_SB(0, 0), cB, voffB); PG8_STAGE(PG8_SB(0, 1), cB + hsB, voffB); PG8_STAGE(PG8_SA(0, 0), cA, voffA); PG8_STAGE(PG8_SA(0, 1), cA + hsA, voffA);
    if (wr == 1) PG8_BAR;
    PG8_WAIT_V(2); PG8_BAR;
    PG8_STAGE(PG8_SB(1, 0), cB + ksB, voffB); PG8_STAGE(PG8_SA(1, 0), cA + ksA, voffA); PG8_STAGE(PG8_SB(1, 1), cB + hsB + ksB, voffB);
    PG8_WAIT_V(6); PG8_BAR;
    for (;;) {
        const bool has_next = S.next(ui + 1, nxt);
        const char* nA = has_next ? PG8_APTR(nxt) : cA; const char* nB = has_next ? PG8_BPTR(nxt) : cB;
        for (int t = 0; t < nt; t += 2) {
            const bool last = (t == nt - 2);
            const char* a1 = cA + (size_t)(t + 1) * ksA;
            const char* a2 = last ? nA : cA + (size_t)(t + 2) * ksA; const char* b2 = last ? nB : cB + (size_t)(t + 2) * ksB;
            const char* a3 = a2 + ksA; const char* b3 = b2 + ksB;
            PG8_LDB(B0, 0, 0); PG8_LDB(B1, 0, 1); PG8_SCHED; PG8_LDA(At, 0, 0); PG8_STAGE(PG8_SA(1, 1), a1 + hsA, voffA);
            PG8_WAIT_V(8); PG8_WAIT_L(0); PG8_BAR; PG8_MMA(0, 0, At, B0); PG8_MMA(0, 1, At, B1); PG8_BAR; PG8_SCHED;
            PG8_LDA(At, 0, 1); PG8_STAGE(PG8_SB(0, 0), b2, voffB); PG8_STAGE(PG8_SB(0, 1), b2 + hsB, voffB); PG8_STAGE(PG8_SA(0, 0), a2, voffA);
            PG8_WAIT_V(8); PG8_WAIT_L(0); PG8_BAR; PG8_MMA(1, 0, At, B0); PG8_MMA(1, 1, At, B1); PG8_BAR; PG8_SCHED;
            PG8_LDB(B0, 1, 0); PG8_LDB(B1, 1, 1); PG8_SCHED; PG8_LDA(At, 1, 0); PG8_STAGE(PG8_SA(0, 1), a2 + hsA, voffA);
            PG8_WAIT_V(8); PG8_WAIT_L(0); PG8_BAR; PG8_MMA(0, 0, At, B0); PG8_MMA(0, 1, At, B1); PG8_BAR; PG8_SCHED;
            PG8_LDA(At, 1, 1); PG8_STAGE(PG8_SB(1, 0), b3, voffB); PG8_STAGE(PG8_SB(1, 1), b3 + hsB, voffB); PG8_STAGE(PG8_SA(1, 0), a3, voffA);
            PG8_WAIT_V(8); PG8_WAIT_L(0); PG8_BAR; PG8_MMA(1, 0, At, B0); PG8_MMA(1, 1, At, B1); PG8_BAR; PG8_SCHED;
        }
        if constexpr (ALIGN_EPI) { if (wr == 0) PG8_BAR; }
        E(acc, cur, wr, wc, fr, fq);
        if (!has_next) break;
#pragma unroll
        for (int a = 0; a < 2; ++a)
#pragma unroll
            for (int b = 0; b < 2; ++b)
#pragma unroll
                for (int m = 0; m < 4; ++m)
#pragma unroll
                    for (int n = 0; n < 2; ++n) acc[a][b][m][n] = (f32x4){0.f, 0.f, 0.f, 0.f};
        cur = nxt; cA = nA; cB = nB; ++ui;
        if constexpr (ALIGN_EPI) { if (wr == 1) PG8_BAR; }
    }
    PG8_WAIT_V(0);
    if constexpr (!ALIGN_EPI) { if (wr == 0) PG8_BAR; }
    PG8_BAR;
#undef PG8_SA
#undef PG8_SB
#undef PG8_STAGE
#undef PG8_LDA
#undef PG8_LDB
#undef PG8_MMA
#undef PG8_WAIT_V
#undef PG8_WAIT_L
#undef PG8_BAR
#undef PG8_SCHED
#undef PG8_APTR
#undef PG8_BPTR
}
}

constexpr int NWAVES = 8;
constexpr int DM = 4096, DFF = 11008, NB_P = 8, S_P = 2048, NB_S = 2, S_S = 4096;
constexpr int M_P = NB_P * S_P, M_S = NB_S * S_S, MT = M_P + M_S;
constexpr int NHEAD = 32, CHUNK = 128, HD = 128, NGRP = 8, GD = 512;
constexpr float EPS = 1e-6f;
constexpr int KP_P = S_P + 256, KP_S = S_S + 256;
constexpr int FT_P = KP_P / 256, FT_S = KP_S / 256, NFT = NB_P * FT_P + NB_S * FT_S;
constexpr int N_PHASES = 15;
constexpr int N_LAUNCHES = MK_N_LAUNCHES;
static_assert(N_LAUNCHES == 1 || N_LAUNCHES == N_PHASES, "MK_N_LAUNCHES must be 1 or 15");

constexpr size_t MiB = 1u << 20;
constexpr size_t WS_CTL = 0, CTL_ZERO_BYTES = 1 * MiB;
constexpr size_t WS_WIN = 1 * MiB;
constexpr size_t WS_WOA = WS_WIN + (size_t)2 * DM * DM * 2;
constexpr size_t WS_WOB = WS_WOA + (size_t)DM * DM * 2;
constexpr size_t WS_WGU = WS_WOB + (size_t)DM * DM * 2;
constexpr size_t WGU_BYTES = (size_t)2 * DFF * DM * 2;
constexpr size_t WS_WD = WS_WGU + 2 * WGU_BYTES;
constexpr size_t WD_BYTES = (size_t)DM * DFF * 2;
constexpr size_t WS_WSB = WS_WD + 2 * WD_BYTES;
constexpr size_t WS_D512 = WS_WSB + 1 * MiB;
constexpr size_t WS_ADP = WS_D512 + 1 * MiB;
constexpr size_t WS_ADS = WS_ADP + (size_t)S_P * 2 * S_P * 2;
constexpr size_t WS_XN = WS_ADS + (size_t)S_S * 2 * S_S * 2;
constexpr size_t WS_BIG = WS_XN + (size_t)MT * DM * 2;
constexpr size_t BIG_T_OFF = 256 * MiB;
static_assert((size_t)NFT * 256 * DM * 2 <= BIG_T_OFF && BIG_T_OFF + ((size_t)NB_P * KP_P + (size_t)NB_S * KP_S) * DM * 2 <= (size_t)MT * DFF * 2, "fold + T inside BIG");
constexpr size_t WS_END = WS_BIG + (size_t)MT * DFF * 2;
static_assert(WS_WSB % 256 == 0 && WS_XN % 256 == 0 && WS_BIG % 256 == 0, "alignment");
constexpr int CW_TMO = 0;
constexpr int CW_BAR = 4096;

constexpr int RING_OFF = 0, RING_BYTES = 131072;
constexpr int LDSCTL_OFF = RING_BYTES, MISC_OFF = LDSCTL_OFF + 320;
constexpr int LDS_BYTES = 147456;

#define GAS __attribute__((address_space(1)))
#define LAS __attribute__((address_space(3)))
typedef unsigned short bf16;
typedef unsigned v4u __attribute__((ext_vector_type(4)));
typedef unsigned v2u __attribute__((ext_vector_type(2)));
typedef float f32x4 __attribute__((ext_vector_type(4)));
typedef short bf16x8 __attribute__((ext_vector_type(8)));
typedef GAS unsigned gu32;
#define RLX_AGENT __ATOMIC_RELAXED, __HIP_MEMORY_SCOPE_AGENT
__device__ __forceinline__ unsigned pk2(float lo, float hi) { return pg8::cvt_pk_bf16(lo, hi); }
__device__ __forceinline__ float bf_lo(unsigned w) { return __uint_as_float(w << 16); }
__device__ __forceinline__ float bf_hi(unsigned w) { return __uint_as_float(w & 0xffff0000u); }

#define XB_TMO      128
#define XB_XCNT(j)  (256  + 64 * (j))
#define XB_XSUB(j)  (1280 + 64 * (j))
#define XB_XGEN(j)  (2304 + 64 * (j))
#define XB_TOP      3328
#define XB_TOPGEN   3392
#define XCD_BAR_WORDS 3456
#define XB_SPIN_CAP (1u << 18)

__device__ __forceinline__ unsigned xb_ld(unsigned* p)              { return __hip_atomic_load(p, __ATOMIC_RELAXED, __HIP_MEMORY_SCOPE_AGENT); }
__device__ __forceinline__ unsigned xb_add(unsigned* p, unsigned v) { return __hip_atomic_fetch_add(p, v, __ATOMIC_RELAXED, __HIP_MEMORY_SCOPE_AGENT); }
__device__ __forceinline__ unsigned xb_xcc_id() { return (unsigned)__builtin_amdgcn_s_getreg((3 << 11) | 20) & 0xFu; }
#define XB_SPIN(cond, bar) do { unsigned _sp = 0; while (cond) { __builtin_amdgcn_s_sleep(1); \
    if ((++_sp & 255u) == 0u) { if (xb_ld(&(bar)[XB_TMO])) break; if (_sp > XB_SPIN_CAP) { atomicAdd(&(bar)[XB_TMO], 1u); break; } } } } while (0)

struct XcdBarrier {
    unsigned* bar; unsigned x;
    volatile LAS unsigned* st;
};
__device__ __forceinline__ XcdBarrier xcd_barrier_post(unsigned* bar, volatile LAS unsigned* st) {
    XcdBarrier b; b.bar = bar; b.x = xb_xcc_id(); b.st = st;
    if (threadIdx.x == 0) (void)xb_add(&bar[XB_XCNT(b.x)], 1u);
    return b;
}
__device__ __forceinline__ void xcd_barrier_complete(unsigned* bar, unsigned x, unsigned& nloc, unsigned& nx) {
    const unsigned G = gridDim.x * gridDim.y * gridDim.z;
    unsigned sum, cnt, mine, sp = 0u;
    for (;;) {
        sum = 0u; cnt = 0u; mine = 0u;
#pragma unroll
        for (unsigned j = 0; j < 16; ++j) { const unsigned c = xb_ld(&bar[XB_XCNT(j)]); sum += c; cnt += (c > 0u) ? 1u : 0u; mine = (j == x) ? c : mine; }
        if (sum == G) break;
        __builtin_amdgcn_s_sleep(1);
        if ((++sp & 255u) == 0u) { if (xb_ld(&bar[XB_TMO])) break; if (sp > XB_SPIN_CAP) { atomicAdd(&bar[XB_TMO], 1u); break; } }
    }
    nloc = mine > 0u ? mine : 1u; nx = cnt > 0u ? cnt : 1u;
}
__device__ __forceinline__ void xcd_barrier(const XcdBarrier& b) {
    asm volatile("s_waitcnt vmcnt(0)" ::: "memory");
    __syncthreads();
    if (threadIdx.x == 0) {
        unsigned* bar = b.bar;
        __builtin_amdgcn_s_waitcnt(0);
        unsigned nloc = b.st[0], nx = b.st[1];
        if (nloc == 0u) { xcd_barrier_complete(bar, b.x, nloc, nx); b.st[0] = nloc; b.st[1] = nx; }
        const unsigned old = xb_add(&bar[XB_XSUB(b.x)], 1u);
        const unsigned gen = old / nloc;
        if (old + 1u == (gen + 1u) * nloc) {
            __builtin_amdgcn_fence(__ATOMIC_RELEASE, "agent");
            asm volatile("s_waitcnt vmcnt(0)" ::: "memory");
            const unsigned og = xb_add(&bar[XB_TOP], 1u);
            const unsigned tg = og / nx;
            if (og + 1u == (tg + 1u) * nx) xb_add(&bar[XB_TOPGEN], 1u);
            else XB_SPIN(xb_ld(&bar[XB_TOPGEN]) == tg, bar);
            __builtin_amdgcn_fence(__ATOMIC_ACQUIRE, "agent");
            xb_add(&bar[XB_XGEN(b.x)], 1u);
            asm volatile("s_waitcnt vmcnt(0)" ::: "memory");
        } else {
            XB_SPIN(xb_ld(&bar[XB_XGEN(b.x)]) == gen, bar);
            __builtin_amdgcn_fence(__ATOMIC_ACQUIRE, "agent");
            asm volatile("s_waitcnt vmcnt(0)" ::: "memory");
        }
    }
    __syncthreads();
}

struct Args { const float* in[16]; float* out; unsigned char* ws; int ph_lo, ph_hi; };
struct Frame {
    LAS unsigned char* lds;
    int tid, lane, wave, vcu, G;
};
__device__ __forceinline__ float wave_sum(float v) {
#pragma unroll
    for (int o = 1; o < 64; o <<= 1) v += __shfl_xor(v, o);
    return v;
}

__device__ __forceinline__ void p0_transpose_item(const float* W, int K, int N, bf16* WT, int mode, LAS float* scr, int item, int lane) {
    const int nblk = N / 32, kb = item / nblk, nb = item - kb * nblk, k0 = 64 * kb, n0 = 32 * nb;
#pragma unroll 8
    for (int i = 0; i < 32; ++i) { const int kk = 2 * i + (lane >> 5); scr[kk * 33 + (lane & 31)] = W[(size_t)(k0 + kk) * N + n0 + (lane & 31)]; }
    asm volatile("s_waitcnt lgkmcnt(0)" ::: "memory");
    const int c = lane & 7;
    const int drow0 = (mode == 0) ? n0 : ((n0 >> 7) * 256 + (n0 & 127) + (mode == 2 ? 128 : 0));
#pragma unroll
    for (int j = 0; j < 4; ++j) { const int n = (lane >> 3) + 8 * j; const LAS float* s = scr + (8 * c) * 33 + n;
        v4u o; o.x = pk2(s[0 * 33], s[1 * 33]); o.y = pk2(s[2 * 33], s[3 * 33]); o.z = pk2(s[4 * 33], s[5 * 33]); o.w = pk2(s[6 * 33], s[7 * 33]);
        { const int dr = drow0 + n; *(v4u*)(WT + ((size_t)(dr >> 8) * (K >> 6) + (k0 >> 6)) * 16384 + (size_t)(dr & 255) * 64 + 8 * c) = o; } }
    asm volatile("s_waitcnt lgkmcnt(0)" ::: "memory");
}

template <bool OUT_F32>
__device__ __forceinline__ void rmsnorm_rows(const Frame& F, const float* src0, const float* src1, int split_row, const float* g, bf16* outb, float* outf) {
    const int gw = F.vcu * NWAVES + F.wave, NGW = F.G * NWAVES;
    for (int m = gw; m < MT; m += NGW) {
        const float* xrow = (m < split_row) ? src0 + (size_t)m * DM : src1 + (size_t)(m - split_row) * DM;
        const f32x4* xr = (const f32x4*)xrow + F.lane;
        f32x4 v[16]; float s = 0.f;
#pragma unroll
        for (int j = 0; j < 16; ++j) { v[j] = xr[64 * j]; s += (v[j].x * v[j].x + v[j].y * v[j].y) + (v[j].z * v[j].z + v[j].w * v[j].w); }
        const float r = 1.0f / sqrtf(wave_sum(s) * (1.0f / DM) + EPS);
        const f32x4* gr = (const f32x4*)g + F.lane;
        if (OUT_F32) { f32x4* o = (f32x4*)(outf + (size_t)m * DM) + F.lane;
#pragma unroll
            for (int j = 0; j < 16; ++j) { const f32x4 gg = gr[64 * j]; o[64 * j] = v[j] * r * gg; } }
        else { v2u* o = (v2u*)(outb + (size_t)m * DM) + F.lane;
#pragma unroll
            for (int j = 0; j < 16; ++j) { const f32x4 gg = gr[64 * j]; const f32x4 y = v[j] * r * gg; v2u w; w.x = pk2(y.x, y.y); w.y = pk2(y.z, y.w); o[64 * j] = w; } }
    }
}

__device__ __forceinline__ void p0_prologue(const Frame& F, const Args& a) {
    unsigned char* ws = a.ws;
    LAS float* scr = (LAS float*)(F.lds + RING_OFF + F.wave * 16384);
    const int gw = F.vcu * NWAVES + F.wave, NGW = F.G * NWAVES;
    constexpr int I_IN = (DM / 64) * (2 * DM / 32), I_O = (DM / 64) * (DM / 32), I_GU = (DM / 64) * (DFF / 32), I_D = (DFF / 64) * (DM / 32);
    constexpr int NITEMS = I_IN + 2 * I_O + 4 * I_GU + 2 * I_D;
    for (int it = gw; it < NITEMS; it += NGW) {
        int r = it;
        if (r < I_IN) { p0_transpose_item(a.in[3], DM, 2 * DM, (bf16*)(ws + WS_WIN), 0, scr, r, F.lane); continue; } r -= I_IN;
        if (r < I_O) { p0_transpose_item(a.in[8], DM, DM, (bf16*)(ws + WS_WOA), 0, scr, r, F.lane); continue; } r -= I_O;
        if (r < I_O) { p0_transpose_item(a.in[10], DM, DM, (bf16*)(ws + WS_WOB), 0, scr, r, F.lane); continue; } r -= I_O;
        if (r < 4 * I_GU) { const int q = r / I_GU, l = q >> 1, up = q & 1; r -= q * I_GU;
            p0_transpose_item(a.in[up ? 13 : 12] + (size_t)l * DM * DFF, DM, DFF, (bf16*)(ws + WS_WGU + (size_t)l * WGU_BYTES), 1 + up, scr, r, F.lane); continue; } r -= 4 * I_GU;
        { const int l = r / I_D; r -= l * I_D; p0_transpose_item(a.in[14] + (size_t)l * DFF * DM, DFF, DM, (bf16*)(ws + WS_WD + (size_t)l * WD_BYTES), 0, scr, r, F.lane); }
    }
    const int gt = (F.vcu * NWAVES + F.wave) * 64 + F.lane, NGT = F.G * NWAVES * 64;
    for (int i = gt; i < NHEAD * CHUNK * CHUNK / 8; i += NGT) { const f32x4 x0 = ((const f32x4*)a.in[6])[2 * i], x1 = ((const f32x4*)a.in[6])[2 * i + 1];
        v4u o; o.x = pk2(x0.x, x0.y); o.y = pk2(x0.z, x0.w); o.z = pk2(x1.x, x1.y); o.w = pk2(x1.z, x1.w); ((v4u*)(ws + WS_WSB))[i] = o; }
    for (int i = gt; i < 1024 * 512 / 8; i += NGT) { const int r = i >> 6, c0 = (i & 63) * 8, k2 = r & 511, cs = r >> 9; float v[8];
#pragma unroll
        for (int j = 0; j < 8; ++j) { const int idx = (k2 * (c0 + j)) & 511; float sn, cn; sincospif((float)idx * (2.0f / 512.0f), &sn, &cn); v[j] = cs ? sn : cn; }
        v4u o; o.x = pk2(v[0], v[1]); o.y = pk2(v[2], v[3]); o.z = pk2(v[4], v[5]); o.w = pk2(v[6], v[7]); ((v4u*)(ws + WS_D512))[i] = o; }
#pragma unroll
    for (int which = 0; which < 2; ++which) {
        const int S = which ? S_S : S_P, KP = S + 256, kp8 = KP / 8; bf16* AD = (bf16*)(ws + (which ? WS_ADS : WS_ADP)); const float inv = 2.0f / (float)S;
        for (int i = gt; i < S * kp8; i += NGT) { const int k1 = i / kp8, k0 = (i - k1 * kp8) * 8; float v[8];
#pragma unroll
            for (int j = 0; j < 8; ++j) { const int k = k0 + j; int sidx; bool is_cos, zero = false;
                if (k <= S / 2) { sidx = k; is_cos = true; } else if (k < S / 2 + 256) { sidx = 0; is_cos = true; zero = true; } else { sidx = k - (S / 2 + 256) + 1; is_cos = false; zero = sidx > S / 2 - 1; }
                const int idx = (k1 * sidx) & (S - 1); float sn, cn; sincospif((float)idx * inv, &sn, &cn); v[j] = zero ? 0.0f : (is_cos ? cn : -sn); }
            v4u o; o.x = pk2(v[0], v[1]); o.y = pk2(v[2], v[3]); o.z = pk2(v[4], v[5]); o.w = pk2(v[6], v[7]);
            *(v4u*)(AD + (size_t)k1 * KP + k0) = o; }
    }
    rmsnorm_rows<false>(F, a.in[0], a.in[1], M_P, a.in[2], (bf16*)(ws + WS_XN), nullptr);
}

__device__ __forceinline__ void gate_phase(const Frame& F, const Args& a) {
    const bf16* Z = (const bf16*)(a.ws + WS_BIG); bf16* Gout = (bf16*)(a.ws + WS_XN); const bf16* WSB = (const bf16*)(a.ws + WS_WSB);
    const float* ln_g = a.in[4]; const float* ln_b = a.in[5]; const float* b_s = a.in[7];
    LAS float* st = (LAS float*)(F.lds + RING_OFF);
    LAS bf16* Vt = (LAS bf16*)(F.lds + RING_OFF + 4096);
    constexpr int VP = 136;
    const int t = F.tid, lane = F.lane, w = F.wave, fr = lane & 15, fq = lane >> 4;
    for (int unit = F.vcu; unit < (MT / CHUNK) * 4; unit += F.G) {
        const int chunk = unit >> 2, hg = unit & 3, r0 = chunk * CHUNK;
        for (int rr = 0; rr < 16; ++rr) { const int q = 16 * w + rr;
            const v4u* vr = (const v4u*)(Z + (size_t)(r0 + q) * (2 * DM) + DM) + lane; v4u raw[8]; float s = 0.f;
#pragma unroll
            for (int j = 0; j < 8; ++j) { raw[j] = vr[64 * j]; s += (bf_lo(raw[j].x) + bf_hi(raw[j].x)) + (bf_lo(raw[j].y) + bf_hi(raw[j].y)) + (bf_lo(raw[j].z) + bf_hi(raw[j].z)) + (bf_lo(raw[j].w) + bf_hi(raw[j].w)); }
            const float mean = wave_sum(s) * (1.0f / DM); float s2 = 0.f;
#pragma unroll
            for (int j = 0; j < 8; ++j) {
#pragma unroll
                for (int e = 0; e < 4; ++e) { const float d0 = bf_lo(raw[j][e]) - mean, d1 = bf_hi(raw[j][e]) - mean; s2 += d0 * d0 + d1 * d1; } }
            const float rstd = 1.0f / sqrtf(wave_sum(s2) * (1.0f / DM) + EPS);
            if (lane == 0) { st[2 * q] = mean; st[2 * q + 1] = rstd; } }
        __syncthreads();
        for (int hh = 0; hh < 8; ++hh) { const int h = hg * 8 + hh;
            { const int q = t >> 2, cs = (t & 3) * 32; const float mean = st[2 * q], rstd = st[2 * q + 1];
              const v4u* src = (const v4u*)(Z + (size_t)(r0 + q) * (2 * DM) + DM + h * HD + cs);
              const f32x4* gp = (const f32x4*)(ln_g + h * HD + cs); const f32x4* bp = (const f32x4*)(ln_b + h * HD + cs);
#pragma unroll
              for (int i = 0; i < 4; ++i) { const v4u raw = src[i]; const f32x4 g0 = gp[2 * i], g1 = gp[2 * i + 1], b0 = bp[2 * i], b1 = bp[2 * i + 1];
                  float y[8];
                  y[0] = (bf_lo(raw.x) - mean) * rstd * g0.x + b0.x; y[1] = (bf_hi(raw.x) - mean) * rstd * g0.y + b0.y; y[2] = (bf_lo(raw.y) - mean) * rstd * g0.z + b0.z; y[3] = (bf_hi(raw.y) - mean) * rstd * g0.w + b0.w;
                  y[4] = (bf_lo(raw.z) - mean) * rstd * g1.x + b1.x; y[5] = (bf_hi(raw.z) - mean) * rstd * g1.y + b1.y; y[6] = (bf_lo(raw.w) - mean) * rstd * g1.z + b1.z; y[7] = (bf_hi(raw.w) - mean) * rstd * g1.w + b1.w;
#pragma unroll
                  for (int e = 0; e < 8; e += 2) { const unsigned pk = pk2(y[e], y[e + 1]); Vt[(cs + 8 * i + e) * VP + q] = (bf16)(pk & 0xffffu); Vt[(cs + 8 * i + e + 1) * VP + q] = (bf16)(pk >> 16); } } }
            __syncthreads();
            const int p = 16 * w + fr;
            bf16x8 af[4];
#pragma unroll
            for (int ks = 0; ks < 4; ++ks) af[ks] = *(const bf16x8*)(WSB + ((size_t)h * CHUNK + p) * CHUNK + 32 * ks + 8 * fq);
            const float bias = b_s[h * CHUNK + p];
#pragma unroll
            for (int ct = 0; ct < 8; ++ct) { f32x4 acc = (f32x4){0.f, 0.f, 0.f, 0.f};
#pragma unroll
                for (int ks = 0; ks < 4; ++ks) { const bf16x8 bfr = *(const LAS bf16x8*)(Vt + (16 * ct + fr) * VP + 32 * ks + 8 * fq); acc = __builtin_amdgcn_mfma_f32_16x16x32_bf16(bfr, af[ks], acc, 0, 0, 0); }
                const int c = 16 * ct + 4 * fq;
                const v2u uu = *(const v2u*)(Z + (size_t)(r0 + p) * (2 * DM) + h * HD + c);
                v2u o; o.x = pk2(bf_lo(uu.x) * (acc[0] + bias), bf_hi(uu.x) * (acc[1] + bias)); o.y = pk2(bf_lo(uu.y) * (acc[2] + bias), bf_hi(uu.y) * (acc[3] + bias));
                *(v2u*)(Gout + (size_t)(r0 + p) * DM + h * HD + c) = o; }
            __syncthreads();
        }
    }
}

__device__ __forceinline__ void fold_norm_phase(const Frame& F, const float* x, const float* g, bf16* FOLD) {
    const int gw = F.vcu * NWAVES + F.wave, NGW = F.G * NWAVES;
    constexpr int IT_P = S_P / 2 + 1, IT_S = S_S / 2 + 1, NIT = NB_P * IT_P + NB_S * IT_S;
    const f32x4* gr = (const f32x4*)g + F.lane;
    for (int it = gw; it < NIT; it += NGW) {
        int b, s, S, KP; size_t tok0, frow0;
        if (it < NB_P * IT_P) { b = it / IT_P; s = it - b * IT_P; S = S_P; KP = KP_P; tok0 = (size_t)b * S_P; frow0 = (size_t)b * KP_P; }
        else { const int r = it - NB_P * IT_P; b = r / IT_S; s = r - b * IT_S; S = S_S; KP = KP_S; tok0 = (size_t)M_P + (size_t)b * S_S; frow0 = (size_t)NB_P * KP_P + (size_t)b * KP_S; }
        const bool single = (s == 0) || (s == S / 2);
        const f32x4* xa = (const f32x4*)(x + (tok0 + s) * DM) + F.lane; const f32x4* xb = (const f32x4*)(x + (tok0 + (single ? s : S - s)) * DM) + F.lane;
        f32x4 va[16], vb[16]; float sa = 0.f, sb = 0.f;
#pragma unroll
        for (int j = 0; j < 16; ++j) { va[j] = xa[64 * j]; vb[j] = xb[64 * j]; sa += (va[j].x * va[j].x + va[j].y * va[j].y) + (va[j].z * va[j].z + va[j].w * va[j].w); sb += (vb[j].x * vb[j].x + vb[j].y * vb[j].y) + (vb[j].z * vb[j].z + vb[j].w * vb[j].w); }
        const float ra = 1.0f / sqrtf(wave_sum(sa) * (1.0f / DM) + EPS), rb = single ? 0.0f : 1.0f / sqrtf(wave_sum(sb) * (1.0f / DM) + EPS);
        v2u* oe = (v2u*)(FOLD + (frow0 + s) * DM) + F.lane; v2u* oo = (v2u*)(FOLD + (frow0 + S / 2 + 256 + (s - 1)) * DM) + F.lane;
#pragma unroll
        for (int j = 0; j < 16; ++j) { const f32x4 gg = gr[64 * j]; const f32x4 ya = va[j] * ra * gg, yb = vb[j] * rb * gg; const f32x4 he = ya + yb, ho = ya - yb;
            v2u w; w.x = pk2(he.x, he.y); w.y = pk2(he.z, he.w); oe[64 * j] = w;
            if (!single) { v2u q; q.x = pk2(ho.x, ho.y); q.y = pk2(ho.z, ho.w); oo[64 * j] = q; } }
    }
    for (int it = gw; it < (NB_P + NB_S) * 256; it += NGW) { const int bb = it >> 8, k = it & 255; int S; size_t frow0;
        if (bb < NB_P) { S = S_P; frow0 = (size_t)bb * KP_P; } else { S = S_S; frow0 = (size_t)NB_P * KP_P + (size_t)(bb - NB_P) * KP_S; }
        const size_t row = frow0 + (k < 255 ? (size_t)(S / 2 + 1 + k) : (size_t)(S + 255));
        v2u* o = (v2u*)(FOLD + row * DM) + F.lane; v2u z; z.x = 0u; z.y = 0u;
#pragma unroll
        for (int j = 0; j < 16; ++j) o[64 * j] = z; }
}

__global__ void __launch_bounds__(NWAVES * 64, 2) mega_fwd(Args args) {
    extern __shared__ __attribute__((aligned(16))) unsigned char lds_raw[];
    Frame F;
    F.lds = (LAS unsigned char*)lds_raw;
    F.tid = threadIdx.x; F.lane = F.tid & 63; F.wave = __builtin_amdgcn_readfirstlane(F.tid >> 6);
    F.G = gridDim.x; { const int bx = blockIdx.x; F.vcu = (F.G % 8 == 0) ? (bx % 8) * (F.G / 8) + bx / 8 : bx; }
    unsigned char* ws = args.ws;
    gu32* ctl = (gu32*)(ws + WS_CTL);
    volatile LAS unsigned* MISC = (volatile LAS unsigned*)(F.lds + MISC_OFF);
    for (int u = F.tid; u < (LDS_BYTES - LDSCTL_OFF) / 4; u += NWAVES * 64) ((LAS unsigned*)(F.lds + LDSCTL_OFF))[u] = 0u;
    __syncthreads();
    XcdBarrier bar; bar.bar = (unsigned*)(ctl + CW_BAR); bar.x = 0; bar.st = nullptr;
    if (N_LAUNCHES == 1) bar = xcd_barrier_post((unsigned*)(ctl + CW_BAR), MISC + 8);
    const int lo = args.ph_lo, hi = args.ph_hi;
#define IN(k) (lo <= (k) && (k) < hi)
#define SEAM(k) do { if (IN(k) && IN((k) + 1)) xcd_barrier(bar); } while (0)
    LAS unsigned char* ring = F.lds + RING_OFF;
    const int bx = (int)blockIdx.x;
    bf16* XN = (bf16*)(ws + WS_XN); bf16* BIG = (bf16*)(ws + WS_BIG);
    const float* xp = args.in[0]; const float* xs = args.in[1];

    if (IN(0)) { p0_prologue(F, args); } SEAM(0);
    if (IN(1)) { pg8::Gemm g{XN, (const bf16*)(ws + WS_WIN), DM, 64, DM, 0, 0, (size_t)256 * DM, (size_t)256 * DM, 128, 32768}; pg8::Order S; S.init(MT / 256, 2 * DM / 256, 1, F.G, bx);
        pg8::EpiGelu E{BIG, 2 * DM}; pg8::gemm_phase<pg8::EpiGelu>(ring, g, S, E); } SEAM(1);
    if (IN(2)) { gate_phase(F, args); } SEAM(2);
    if (IN(3)) { pg8::Gemm g{XN, (const bf16*)(ws + WS_WOA), DM, 64, DM, 0, 0, (size_t)256 * DM, (size_t)256 * DM, 128, 32768}; pg8::Order S; S.init(MT / 256, DM / 256, 1, F.G, bx);
        pg8::EpiRes E{xp, xs, M_P / 256, args.out, DM}; pg8::gemm_phase<pg8::EpiRes>(ring, g, S, E); } SEAM(3);
    if (IN(4)) { rmsnorm_rows<false>(F, args.out, args.out, MT, args.in[11], XN, nullptr); } SEAM(4);
    if (IN(5)) { pg8::Gemm g{XN, (const bf16*)(ws + WS_WGU), DM, 64, DM, 0, 0, (size_t)256 * DM, (size_t)256 * DM, 128, 32768}; pg8::Order S; S.init(MT / 256, 2 * DFF / 256, 1, F.G, bx);
        pg8::EpiSwiglu E{BIG, DFF}; pg8::gemm_phase<pg8::EpiSwiglu>(ring, g, S, E); } SEAM(5);
    if (IN(6)) { pg8::Gemm g{BIG, (const bf16*)(ws + WS_WD), DFF, 64, DFF, 0, 0, (size_t)256 * DFF, (size_t)256 * DFF, 128, 32768}; pg8::Order S; S.init(MT / 256, DM / 256, 1, F.G, bx);
        pg8::EpiRes E{args.out, args.out, 1 << 30, args.out, DM}; pg8::gemm_phase<pg8::EpiRes>(ring, g, S, E); } SEAM(6);
    bf16* FOLD = BIG; bf16* TB = (bf16*)(ws + WS_BIG + BIG_T_OFF);
    const pg8::FoldGeom fgeo{NB_P * FT_P, FT_P, FT_S, KP_P, KP_S, NB_P};
    if (IN(7)) { fold_norm_phase(F, args.out, args.in[9], FOLD); } SEAM(7);
    if (IN(8)) { pg8::Gemm g{(const bf16*)(ws + WS_D512), FOLD, GD, DM, GD, 0, (size_t)GD, (size_t)256 * GD, (size_t)256 * DM, 128, 128}; pg8::OrderFour S; S.init(NFT, NGRP, F.G, bx, fgeo);
        pg8::EpiFourA E{TB, fgeo}; pg8::gemm_phase<pg8::EpiFourA, pg8::OrderFour>(ring, g, S, E); } SEAM(8);
    if (IN(9)) {
        { pg8::Gemm g{(const bf16*)(ws + WS_ADP), TB, KP_P, KP_P, KP_P, 0, (size_t)DM * KP_P, (size_t)256 * KP_P, (size_t)256 * KP_P, 128, 128}; pg8::Order S; S.init(S_P / 256, DM / 256, NB_P, F.G, bx);
          pg8::EpiScale E{XN, DM, 0.0009765625f  , S_P}; pg8::gemm_phase<pg8::EpiScale>(ring, g, S, E); }
        { pg8::Gemm g{(const bf16*)(ws + WS_ADS), TB + (size_t)NB_P * DM * KP_P, KP_S, KP_S, KP_S, 0, (size_t)DM * KP_S, (size_t)256 * KP_S, (size_t)256 * KP_S, 128, 128}; pg8::Order S; S.init(S_S / 256, DM / 256, NB_S, F.G, bx);
          pg8::EpiScale E{XN + (size_t)M_P * DM, DM, 0.00069053396600248784f  , S_S}; pg8::gemm_phase<pg8::EpiScale>(ring, g, S, E); }
    } SEAM(9);
    if (IN(10)) { pg8::Gemm g{XN, (const bf16*)(ws + WS_WOB), DM, 64, DM, 0, 0, (size_t)256 * DM, (size_t)256 * DM, 128, 32768}; pg8::Order S; S.init(MT / 256, DM / 256, 1, F.G, bx);
        pg8::EpiRes E{args.out, args.out, 1 << 30, args.out, DM}; pg8::gemm_phase<pg8::EpiRes>(ring, g, S, E); } SEAM(10);
    if (IN(11)) { rmsnorm_rows<false>(F, args.out, args.out, MT, args.in[11] + DM, XN, nullptr); } SEAM(11);
    if (IN(12)) { pg8::Gemm g{XN, (const bf16*)(ws + WS_WGU + WGU_BYTES), DM, 64, DM, 0, 0, (size_t)256 * DM, (size_t)256 * DM, 128, 32768}; pg8::Order S; S.init(MT / 256, 2 * DFF / 256, 1, F.G, bx);
        pg8::EpiSwiglu E{BIG, DFF}; pg8::gemm_phase<pg8::EpiSwiglu>(ring, g, S, E); } SEAM(12);
    if (IN(13)) { pg8::Gemm g{BIG, (const bf16*)(ws + WS_WD + WD_BYTES), DFF, 64, DFF, 0, 0, (size_t)256 * DFF, (size_t)256 * DFF, 128, 32768}; pg8::Order S; S.init(MT / 256, DM / 256, 1, F.G, bx);
        pg8::EpiRes E{args.out, args.out, 1 << 30, args.out, DM}; pg8::gemm_phase<pg8::EpiRes>(ring, g, S, E); } SEAM(13);
    if (IN(14)) {
        rmsnorm_rows<true>(F, args.out, args.out, MT, args.in[15], nullptr, args.out);
        if (N_LAUNCHES == 1 && __hip_atomic_load((unsigned*)(ctl + CW_BAR) + XB_TMO, RLX_AGENT) != 0u) {
            const int gw = F.vcu * NWAVES + F.wave, NGW = F.G * NWAVES; const float q = __builtin_nanf("");
            for (int m = gw; m < MT; m += NGW) { f32x4* o = (f32x4*)(args.out + (size_t)m * DM) + F.lane;
#pragma unroll
                for (int j = 0; j < 16; ++j) o[64 * j] = (f32x4){q, q, q, q}; } }
    }
#undef IN
#undef SEAM
}

extern "C" void kernel_launch(void* const* d_in, const int* in_sizes, int n_in, void* d_out, int out_size, void* d_ws, size_t ws_size, hipStream_t stream) {
    static int grid = 0;
    if (grid == 0) {
        if (n_in != 16 || in_sizes[0] != M_P * DM || in_sizes[1] != M_S * DM || out_size != MT * DM || ws_size < WS_END) {
            fprintf(stderr, "kernel_launch: unexpected shapes (n_in %d, out %d, ws %zu, need %zu); nothing launched\n", n_in, out_size, ws_size, (size_t)WS_END); grid = -1; return; }
        int dev = 0, cus = 0, per_cu = 0;
        if (hipGetDevice(&dev) != hipSuccess || hipDeviceGetAttribute(&cus, hipDeviceAttributeMultiprocessorCount, dev) != hipSuccess) { grid = -1; return; }
        if (hipFuncSetAttribute((const void*)mega_fwd, hipFuncAttributeMaxDynamicSharedMemorySize, LDS_BYTES) != hipSuccess) { fprintf(stderr, "kernel_launch: hipFuncSetAttribute failed\n"); grid = -1; return; }
        if (hipOccupancyMaxActiveBlocksPerMultiprocessor(&per_cu, (const void*)mega_fwd, NWAVES * 64, LDS_BYTES) != hipSuccess || per_cu < 1)
            fprintf(stderr, "kernel_launch: note: occupancy query reports %d workgroups per CU\n", per_cu);
        (void)hipGetLastError();
        grid = cus;
    }
    if (grid < 0) return;
    if (hipMemsetAsync((char*)d_ws + WS_CTL, 0, CTL_ZERO_BYTES, stream) != hipSuccess) return;
    Args a{};
    for (int i = 0; i < 16; ++i) a.in[i] = (const float*)d_in[i];
    a.out = (float*)d_out; a.ws = (unsigned char*)d_ws;
    for (int li = 0; li < N_LAUNCHES; ++li) {
        a.ph_lo = (N_LAUNCHES == 1) ? 0 : li; a.ph_hi = (N_LAUNCHES == 1) ? N_PHASES : li + 1;
        hipLaunchKernelGGL(mega_fwd, dim3(grid), dim3(NWAVES * 64), LDS_BYTES, stream, a);
        const hipError_t le = hipPeekAtLastError();
        if (le != hipSuccess) { fprintf(stderr, "kernel_launch: launch %d failed: %s\n", li, hipGetErrorName(le)); break; }
    }
}
```

```cpp
#include <hip/hip_runtime.h>
#include <cstdio>
#include <cstdint>

#ifndef MK_N_LAUNCHES
#define MK_N_LAUNCHES 1
#endif

namespace pg8 {
#define PG8_LAS __attribute__((address_space(3)))
typedef unsigned short bf16_t;
typedef short bf16x8 __attribute__((ext_vector_type(8)));
typedef float f32x4 __attribute__((ext_vector_type(4)));
typedef float f32x2 __attribute__((ext_vector_type(2)));
typedef unsigned u32x4 __attribute__((ext_vector_type(4)));
constexpr int BM = 256, BK = 64, HALF = 128, HTB = HALF * BK * 2  , STAGE_BYTES = 8 * HTB, NXCD = 8, WGM = 8;

__host__ __device__ __forceinline__ int lds_byte(int r, int c) { const int st = (r >> 4) * 2 + (c >> 5), rr = r & 15, cc = c & 31, ob = rr * 64 + cc * 2; return st * 1024 + (ob ^ (((ob >> 9) & 1) << 5)); }
__host__ __device__ __forceinline__ void stage_rc(int b, int& R, int& C) { const int st = b / 1024, sb = b % 1024, swz = sb ^ (((sb >> 9) & 1) << 5); R = (st >> 1) * 16 + swz / 64; C = (st & 1) * 32 + (swz % 64) / 2; }
__host__ __device__ __forceinline__ int perm32(int rho) { const int n = rho >> 4, i = rho & 15; return 8 * (i >> 2) + 4 * n + (i & 3); }

struct Unit { int pm, pn, aux; };
struct Gemm { const bf16_t* A; const bf16_t* Bt; int lda, ldb, K; size_t a_aux, b_aux; size_t a_tile, b_tile; int ksA, ksB; };

struct Order {
    int nM, nN, per, nwg, G, c;
    __device__ __forceinline__ void init(int nM_, int nN_, int nAux_, int G_, int c_) { nM = nM_; nN = nN_; per = nM_ * nN_; nwg = per * nAux_; G = G_; c = c_; }
    __device__ __forceinline__ bool next(int i, Unit& u) const {
        const long L = (long)i * G + c; if (L >= nwg) return false;
        int wgid = (int)L; { const int q = nwg / NXCD, r = nwg % NXCD, xcd = wgid % NXCD, off = wgid / NXCD; wgid = (xcd < r ? xcd * (q + 1) : r * (q + 1) + (xcd - r) * q) + off; }
        u.aux = wgid / per; const int w = wgid - u.aux * per;
        const int nig = WGM * nN, gid = w / nig, fm = gid * WGM, gsz = (nM - fm) < WGM ? (nM - fm) : WGM;
        u.pm = fm + ((w % nig) % gsz); u.pn = (w % nig) / gsz; return true;
    }
};

__device__ __forceinline__ unsigned cvt_pk_bf16(float lo, float hi) { unsigned r; asm volatile("v_cvt_pk_bf16_f32 %0, %1, %2" : "=v"(r) : "v"(lo), "v"(hi)); return r; }
__device__ __forceinline__ u32x4 pack8(const f32x4 v0, const f32x4 v1) { u32x4 w; w.x = cvt_pk_bf16(v0[0], v0[1]); w.y = cvt_pk_bf16(v0[2], v0[3]); w.z = cvt_pk_bf16(v1[0], v1[1]); w.w = cvt_pk_bf16(v1[2], v1[3]); return w; }
__device__ __forceinline__ f32x2 gelu_tanh_pk(f32x2 x) {
    const f32x2 x2 = x * x, u = x * (x2 * 0.0356774081f + 0.7978845608f), t = u * (-2.885390082f);
    f32x2 e; e.x = __builtin_amdgcn_exp2f(t.x); e.y = __builtin_amdgcn_exp2f(t.y);
    const f32x2 d = e + 1.0f; f32x2 r; r.x = __builtin_amdgcn_rcpf(d.x); r.y = __builtin_amdgcn_rcpf(d.y);
    return x * r;
}
__device__ __forceinline__ f32x4 gelu4(const f32x4 v) { const f32x2 a = gelu_tanh_pk((f32x2){v[0], v[1]}), b = gelu_tanh_pk((f32x2){v[2], v[3]}); return (f32x4){a.x, a.y, b.x, b.y}; }
__device__ __forceinline__ f32x2 swiglu_pk(f32x2 g, f32x2 u) {
    const f32x2 t = g * (-1.4426950409f); f32x2 e; e.x = __builtin_amdgcn_exp2f(t.x); e.y = __builtin_amdgcn_exp2f(t.y);
    const f32x2 d = e + 1.0f; f32x2 r; r.x = __builtin_amdgcn_rcpf(d.x); r.y = __builtin_amdgcn_rcpf(d.y);
    return g * r * u;
}
__device__ __forceinline__ f32x4 swiglu4(const f32x4 g, const f32x4 u) { const f32x2 a = swiglu_pk((f32x2){g[0], g[1]}, (f32x2){u[0], u[1]}), b = swiglu_pk((f32x2){g[2], g[3]}, (f32x2){u[2], u[3]}); return (f32x4){a.x, a.y, b.x, b.y}; }

struct EpiGelu {
    static constexpr bool PERM = true;
    bf16_t* O; int ldc;
    __device__ __forceinline__ void operator()(const f32x4 (&acc)[2][2][4][2], const Unit& u, int wr, int wc, int fr, int fq) const {
        const int row0 = u.pm * BM + wr * 64 + fr, col0 = u.pn * BM + wc * 32 + 8 * fq;
#pragma unroll
        for (int ai = 0; ai < 2; ++ai)
#pragma unroll
            for (int m = 0; m < 4; ++m) { bf16_t* rowp = O + (size_t)(row0 + ai * HALF + m * 16) * ldc + col0;
#pragma unroll
                for (int bj = 0; bj < 2; ++bj) *(u32x4*)(rowp + bj * HALF) = pack8(gelu4(acc[ai][bj][m][0]), gelu4(acc[ai][bj][m][1])); }
    }
};
struct EpiSwiglu {
    static constexpr bool PERM = true;
    bf16_t* O; int ldc;
    __device__ __forceinline__ void operator()(const f32x4 (&acc)[2][2][4][2], const Unit& u, int wr, int wc, int fr, int fq) const {
        const int row0 = u.pm * BM + wr * 64 + fr, col0 = u.pn * HALF + wc * 32 + 8 * fq;
#pragma unroll
        for (int ai = 0; ai < 2; ++ai)
#pragma unroll
            for (int m = 0; m < 4; ++m) { bf16_t* rowp = O + (size_t)(row0 + ai * HALF + m * 16) * ldc + col0;
                *(u32x4*)rowp = pack8(swiglu4(acc[ai][0][m][0], acc[ai][1][m][0]), swiglu4(acc[ai][0][m][1], acc[ai][1][m][1])); }
    }
};
struct EpiScale {
    static constexpr bool PERM = true;
    bf16_t* O; int ldc; float scale; int aux_rows;
    __device__ __forceinline__ void operator()(const f32x4 (&acc)[2][2][4][2], const Unit& u, int wr, int wc, int fr, int fq) const {
        const int row0 = u.aux * aux_rows + u.pm * BM + wr * 64 + fr, col0 = u.pn * BM + wc * 32 + 8 * fq;
#pragma unroll
        for (int ai = 0; ai < 2; ++ai)
#pragma unroll
            for (int m = 0; m < 4; ++m) { bf16_t* rowp = O + (size_t)(row0 + ai * HALF + m * 16) * ldc + col0;
#pragma unroll
                for (int bj = 0; bj < 2; ++bj) *(u32x4*)(rowp + bj * HALF) = pack8(acc[ai][bj][m][0] * scale, acc[ai][bj][m][1] * scale); }
    }
};
struct EpiRes {
    static constexpr bool PERM = false;
    const float* base0; const float* base1; int split_pm; float* out; int ldc;
    __device__ __forceinline__ void operator()(const f32x4 (&acc)[2][2][4][2], const Unit& u, int wr, int wc, int fr, int fq) const {
        const float* bp = (u.pm < split_pm) ? base0 + (size_t)u.pm * BM * ldc : base1 + (size_t)(u.pm - split_pm) * BM * ldc;
        float* op = out + (size_t)u.pm * BM * ldc;
        const int col0 = u.pn * BM + wc * 32 + 4 * fq;
#pragma unroll
        for (int ai = 0; ai < 2; ++ai)
#pragma unroll
            for (int m = 0; m < 4; ++m) { const size_t off = (size_t)(ai * HALF + wr * 64 + m * 16 + fr) * ldc + col0;
#pragma unroll
                for (int bj = 0; bj < 2; ++bj)
#pragma unroll
                    for (int n = 0; n < 2; ++n) { const f32x4 bs = *(const f32x4*)(bp + off + bj * HALF + n * 16); *(f32x4*)(op + off + bj * HALF + n * 16) = bs + acc[ai][bj][m][n]; }
                asm volatile("" ::: "memory"); }
    }
};
struct FoldGeom { int ntp, tpp, tps, kpp, kps, nbp; };
struct OrderFour {
    int ntile, nwg, G, c; FoldGeom fg;
    __device__ __forceinline__ void init(int ntile_, int ngrp, int G_, int c_, FoldGeom fg_) { ntile = ntile_; nwg = ntile_ * 2 * ngrp; G = G_; c = c_; fg = fg_; }
    __device__ __forceinline__ bool next(int i, Unit& u) const {
        const long L = (long)i * G + c; if (L >= nwg) return false;
        int wgid = (int)L; { const int q = nwg / NXCD, r = nwg % NXCD, xcd = wgid % NXCD, off = wgid / NXCD; wgid = (xcd < r ? xcd * (q + 1) : r * (q + 1) + (xcd - r) * q) + off; }
        const int per = ntile * 2; u.aux = wgid / per; const int w = wgid - u.aux * per, ft = w >> 1;
        const bool ho = (ft < fg.ntp) ? ((ft % fg.tpp) >= (fg.tpp + 1) / 2) : (((ft - fg.ntp) % fg.tps) >= (fg.tps + 1) / 2);
        u.pm = (w & 1) + (ho ? 2 : 0); u.pn = ft; return true;
    }
};
struct EpiFourA {
    static constexpr bool PERM = true;
    bf16_t* T; FoldGeom fg;
    __device__ __forceinline__ void operator()(const f32x4 (&acc)[2][2][4][2], const Unit& u, int wr, int wc, int fr, int fq) const {
        const int ft = u.pn; int KP, tt; size_t tb;
        if (ft < fg.ntp) { const int b = ft / fg.tpp; tt = ft - b * fg.tpp; KP = fg.kpp; tb = (size_t)b * 4096 * fg.kpp; }
        else { const int b = (ft - fg.ntp) / fg.tps; tt = (ft - fg.ntp) - b * fg.tps; KP = fg.kps; tb = (size_t)fg.nbp * 4096 * fg.kpp + (size_t)b * 4096 * fg.kps; }
        const int j0 = tt * BM + wc * 32 + 8 * fq, r0 = u.pm * BM + wr * 64 + fr;
        bf16_t* base = T + tb + j0;
#pragma unroll
        for (int ai = 0; ai < 2; ++ai)
#pragma unroll
            for (int m = 0; m < 4; ++m) { const int k2 = (r0 + ai * HALF + m * 16) & 511;
                bf16_t* p = base + (size_t)(u.aux * 512 + k2) * (size_t)KP;
#pragma unroll
                for (int bj = 0; bj < 2; ++bj) *(u32x4*)(p + bj * HALF) = pack8(acc[ai][bj][m][0], acc[ai][bj][m][1]); }
    }
};

template <class Epi, class Sched = Order, bool ALIGN_EPI = true>
__device__ __forceinline__ void gemm_phase(PG8_LAS unsigned char* lds, const Gemm g, const Sched& S, const Epi& E) {
    const int tid = threadIdx.x, wid = __builtin_amdgcn_readfirstlane(tid >> 6), lane = tid & 63, wr = wid >> 2, wc = wid & 3, fr = lane & 15, fq = lane >> 4;
    const int K = g.K, nt = K / BK;
    unsigned voffA[2], voffB[2];
#pragma unroll
    for (int i = 0; i < 2; ++i) { int R, C; stage_rc(tid * 16 + i * 8192, R, C); const int Rb = Epi::PERM ? ((R & ~31) + perm32(R & 31)) : R;
        voffA[i] = (unsigned)(R * g.lda + C) * 2u; voffB[i] = (unsigned)(Rb * g.ldb + C) * 2u; }
    const size_t ksA = (size_t)g.ksA, ksB = (size_t)g.ksB;
    const size_t hsA = (size_t)HALF * g.lda * 2, hsB = (size_t)HALF * g.ldb * 2;
    const unsigned ldsw = (unsigned)wid * 1024u;
    const int aoff = lds_byte(wr * 64 + fr, fq * 8), boff = lds_byte(wc * 32 + fr, fq * 8);
#define PG8_SA(b, h) (((b) * 2 + (h)) * HTB)
#define PG8_SB(b, h) ((4 + (b) * 2 + (h)) * HTB)
#define PG8_STAGE(bufoff, gbase, voff) do { _Pragma("unroll") for (int _i = 0; _i < 2; ++_i) \
        __builtin_amdgcn_global_load_lds((const unsigned*)((const char*)(gbase) + (voff)[_i]), (PG8_LAS unsigned*)(lds + (bufoff) + ldsw + _i * 8192), 16, 0, 0); } while (0)
#define PG8_LDA(dst, b, h) do { _Pragma("unroll") for (int m = 0; m < 4; ++m) _Pragma("unroll") for (int k = 0; k < 2; ++k) dst[m][k] = *(const PG8_LAS bf16x8*)(lds + PG8_SA(b, h) + aoff + m * 2048 + k * 1024); } while (0)
#define PG8_LDB(dst, b, h) do { _Pragma("unroll") for (int n = 0; n < 2; ++n) _Pragma("unroll") for (int k = 0; k < 2; ++k) dst[n][k] = *(const PG8_LAS bf16x8*)(lds + PG8_SB(b, h) + boff + n * 2048 + k * 1024); } while (0)
#define PG8_MMA(ai, bj, At, Bt) do { __builtin_amdgcn_s_setprio(1); _Pragma("unroll") for (int m = 0; m < 4; ++m) _Pragma("unroll") for (int n = 0; n < 2; ++n) _Pragma("unroll") for (int k = 0; k < 2; ++k) \
        acc[ai][bj][m][n] = __builtin_amdgcn_mfma_f32_16x16x32_bf16(Bt[n][k], At[m][k], acc[ai][bj][m][n], 0, 0, 0); __builtin_amdgcn_s_setprio(0); } while (0)
#define PG8_WAIT_V(n) asm volatile("s_waitcnt vmcnt(" #n ")" ::: "memory")
#define PG8_WAIT_L(n) asm volatile("s_waitcnt lgkmcnt(" #n ")" ::: "memory")
#define PG8_BAR __builtin_amdgcn_s_barrier()
#define PG8_SCHED __builtin_amdgcn_sched_barrier(0)
#define PG8_APTR(u) ((const char*)g.A + ((size_t)(u).pm * g.a_tile + (size_t)(u).aux * g.a_aux) * 2)
#define PG8_BPTR(u) ((const char*)g.Bt + ((size_t)(u).pn * g.b_tile + (size_t)(u).aux * g.b_aux) * 2)
    Unit cur, nxt; int ui = 0;
    if (!S.next(0, cur)) return;
    f32x4 acc[2][2][4][2];
#pragma unroll
    for (int a = 0; a < 2; ++a)
#pragma unroll
        for (int b = 0; b < 2; ++b)
#pragma unroll
            for (int m = 0; m < 4; ++m)
#pragma unroll
                for (int n = 0; n < 2; ++n) acc[a][b][m][n] = (f32x4){0.f, 0.f, 0.f, 0.f};
    bf16x8 At[4][2], B0[2][2], B1[2][2];
    const char* cA = PG8_APTR(cur); const char* cB = PG8_BPTR(cur);
    PG8_STAGE(PG8_SB(0, 0), cB, voffB); PG8_STAGE(PG8_SB(0, 1), cB + hsB, voffB); PG8_STAGE(PG8_SA(0, 0), cA, voffA); PG8_STAGE(PG8_SA(0, 1), cA + hsA, voffA);
    if (wr == 1) PG8_BAR;
    PG8_WAIT_V(2); PG8_BAR;
    PG8_STAGE(PG8_SB(1, 0), cB + ksB, voffB); PG8_STAGE(PG8_SA(1, 0), cA + ksA, voffA); PG8_STAGE(PG8_SB(1, 1), cB + hsB + ksB, voffB);
    PG8_WAIT_V(6); PG8_BAR;
    for (;;) {
        const bool has_next = S.next(ui + 1, nxt);
        const char* nA = has_next ? PG8_APTR(nxt) : cA; const char* nB = has_next ? PG8_BPTR(nxt) : cB;
        for (int t = 0; t < nt; t += 2) {
            const bool last = (t == nt - 2);
            const char* a1 = cA + (size_t)(t + 1) * ksA;
            const char* a2 = last ? nA : cA + (size_t)(t + 2) * ksA; const char* b2 = last ? nB : cB + (size_t)(t + 2) * ksB;
            const char* a3 = a2 + ksA; const char* b3 = b2 + ksB;
            PG8_LDB(B0, 0, 0); PG8_LDB(B1, 0, 1); PG8_SCHED; PG8_LDA(At, 0, 0); PG8_STAGE(PG8_SA(1, 1), a1 + hsA, voffA);
            PG8_WAIT_V(8); PG8_WAIT_L(0); PG8_BAR; PG8_MMA(0, 0, At, B0); PG8_MMA(0, 1, At, B1); PG8_BAR; PG8_SCHED;
            PG8_LDA(At, 0, 1); PG8_STAGE(PG8_SB(0, 0), b2, voffB); PG8_STAGE(PG8_SB(0, 1), b2 + hsB, voffB); PG8_STAGE(PG8_SA(0, 0), a2, voffA);
            PG8_WAIT_V(8); PG8_WAIT_L(0); PG8_BAR; PG8_MMA(1, 0, At, B0); PG8_MMA(1, 1, At, B1); PG8_BAR; PG8_SCHED;
            PG8_LDB(B0, 1, 0); PG8_LDB(B1, 1, 1); PG8_SCHED; PG8_LDA(At, 1, 0); PG8_STAGE(PG8_SA(0, 1), a2 + hsA, voffA);
            PG8_WAIT_V(8); PG8_WAIT_L(0); PG8_BAR; PG8_MMA(0, 0, At, B0); PG8_MMA(0, 1, At, B1); PG8_BAR; PG8_SCHED;
            PG8_LDA(At, 1, 1); PG8_STAGE(PG8_SB(1, 0), b3, voffB); PG8_STAGE(PG8_SB(1, 1), b3 + hsB, voffB); PG8_STAGE(PG8_SA(1, 0), a3, voffA);
            PG8_WAIT_V(8); PG8_WAIT_L(0); PG8_BAR; PG8_MMA(1, 0, At, B0); PG8_MMA(1, 1, At, B1); PG8_BAR; PG8_SCHED;
        }
        if constexpr (ALIGN_EPI) { if (wr == 0) PG8_BAR; }
        E(acc, cur, wr, wc, fr, fq);
        if (!has_next) break;
#pragma unroll
        for (int a = 0; a < 2; ++a)
#pragma unroll
            for (int b = 0; b < 2; ++b)
#pragma unroll
                for (int m = 0; m < 4; ++m)
#pragma unroll
                    for (int n = 0; n < 2; ++n) acc[a][b][m][n] = (f32x4){0.f, 0.f, 0.f, 0.f};
        cur = nxt; cA = nA; cB = nB; ++ui;
        if constexpr (ALIGN_EPI) { if (wr == 1) PG8_BAR; }
    }
    PG8_WAIT_V(0);
    if constexpr (!ALIGN_EPI) { if (wr == 0) PG8_BAR; }
    PG8_BAR;
#undef PG8_SA
#undef PG8_SB
#undef PG8_STAGE
#undef PG8_LDA
#undef PG8_LDB
#undef PG8_MMA
#undef PG8_WAIT_V
#undef PG8_WAIT_L
#undef PG8_BAR
#undef PG8_SCHED
#undef PG8_APTR
#undef PG8_BPTR
}
}

constexpr int NWAVES = 8;
constexpr int DM = 4096, DFF = 11008, NB_P = 8, S_P = 2048, NB_S = 2, S_S = 4096;
constexpr int M_P = NB_P * S_P, M_S = NB_S * S_S, MT = M_P + M_S;
constexpr int NHEAD = 32, CHUNK = 128, HD = 128, NGRP = 8, GD = 512;
constexpr float EPS = 1e-6f;
constexpr int KP_P = S_P + 256, KP_S = S_S + 256;
constexpr int FT_P = KP_P / 256, FT_S = KP_S / 256, NFT = NB_P * FT_P + NB_S * FT_S;
constexpr int N_PHASES = 15;
constexpr int N_LAUNCHES = MK_N_LAUNCHES;
static_assert(N_LAUNCHES == 1, "one launch only (phase 2 carries a grid barrier of its own)");

constexpr size_t MiB = 1u << 20;
constexpr size_t WS_CTL = 0, CTL_ZERO_BYTES = 1 * MiB;
constexpr size_t WS_WIN = 1 * MiB;
constexpr size_t WS_WOA = WS_WIN + (size_t)2 * DM * DM * 2;
constexpr size_t WS_WOB = WS_WOA + (size_t)DM * DM * 2;
constexpr size_t WS_WGU = WS_WOB + (size_t)DM * DM * 2;
constexpr size_t WGU_BYTES = (size_t)2 * DFF * DM * 2;
constexpr size_t WS_WD = WS_WGU + 2 * WGU_BYTES;
constexpr size_t WD_BYTES = (size_t)DM * DFF * 2;
constexpr size_t WS_WSB = WS_WD + 2 * WD_BYTES;
constexpr size_t WS_D512 = WS_WSB + 1 * MiB;
constexpr size_t WS_ADP = WS_D512 + 1 * MiB;
constexpr size_t WS_ADS = WS_ADP + (size_t)S_P * 2 * S_P * 2;
constexpr size_t WS_XN = WS_ADS + (size_t)S_S * 2 * S_S * 2;
constexpr size_t WS_BIG = WS_XN + (size_t)MT * DM * 2;
constexpr size_t BIG_T_OFF = 256 * MiB;
static_assert((size_t)NFT * 256 * DM * 2 <= BIG_T_OFF && BIG_T_OFF + ((size_t)NB_P * KP_P + (size_t)NB_S * KP_S) * DM * 2 <= (size_t)MT * DFF * 2, "fold + T inside BIG");
constexpr size_t WS_END = WS_BIG + (size_t)MT * DFF * 2;
static_assert(WS_WSB % 256 == 0 && WS_XN % 256 == 0 && WS_BIG % 256 == 0, "alignment");
constexpr int CW_TMO = 0;
constexpr int CW_BAR = 4096;
constexpr int CW_STATS = 16384;
static_assert((size_t)(CW_STATS + 2 * MT) * 4 <= CTL_ZERO_BYTES, "control region");

constexpr int RING_OFF = 0, RING_BYTES = 131072;
constexpr int LDSCTL_OFF = RING_BYTES, MISC_OFF = LDSCTL_OFF + 320;
constexpr int LDS_BYTES = 147456;

#define GAS __attribute__((address_space(1)))
#define LAS __attribute__((address_space(3)))
typedef unsigned short bf16;
typedef unsigned v4u __attribute__((ext_vector_type(4)));
typedef unsigned v2u __attribute__((ext_vector_type(2)));
typedef float f32x4 __attribute__((ext_vector_type(4)));
typedef short bf16x8 __attribute__((ext_vector_type(8)));
typedef GAS unsigned gu32;
#define RLX_AGENT __ATOMIC_RELAXED, __HIP_MEMORY_SCOPE_AGENT
__device__ __forceinline__ unsigned pk2(float lo, float hi) { return pg8::cvt_pk_bf16(lo, hi); }
__device__ __forceinline__ float bf_lo(unsigned w) { return __uint_as_float(w << 16); }
__device__ __forceinline__ float bf_hi(unsigned w) { return __uint_as_float(w & 0xffff0000u); }

#define XB_TMO      128
#define XB_XCNT(j)  (256  + 64 * (j))
#define XB_XSUB(j)  (1280 + 64 * (j))
#define XB_XGEN(j)  (2304 + 64 * (j))
#define XB_TOP      3328
#define XB_TOPGEN   3392
#define XCD_BAR_WORDS 3456
#define XB_SPIN_CAP (1u << 18)

__device__ __forceinline__ unsigned xb_ld(unsigned* p)              { return __hip_atomic_load(p, __ATOMIC_RELAXED, __HIP_MEMORY_SCOPE_AGENT); }
__device__ __forceinline__ unsigned xb_add(unsigned* p, unsigned v) { return __hip_atomic_fetch_add(p, v, __ATOMIC_RELAXED, __HIP_MEMORY_SCOPE_AGENT); }
__device__ __forceinline__ unsigned xb_xcc_id() { return (unsigned)__builtin_amdgcn_s_getreg((3 << 11) | 20) & 0xFu; }
#define XB_SPIN(cond, bar) do { unsigned _sp = 0; while (cond) { __builtin_amdgcn_s_sleep(1); \
    if ((++_sp & 255u) == 0u) { if (xb_ld(&(bar)[XB_TMO])) break; if (_sp > XB_SPIN_CAP) { atomicAdd(&(bar)[XB_TMO], 1u); break; } } } } while (0)

struct XcdBarrier {
    unsigned* bar; unsigned x;
    volatile LAS unsigned* st;
};
__device__ __forceinline__ XcdBarrier xcd_barrier_post(unsigned* bar, volatile LAS unsigned* st) {
    XcdBarrier b; b.bar = bar; b.x = xb_xcc_id(); b.st = st;
    if (threadIdx.x == 0) (void)xb_add(&bar[XB_XCNT(b.x)], 1u);
    return b;
}
__device__ __forceinline__ void xcd_barrier_complete(unsigned* bar, unsigned x, unsigned& nloc, unsigned& nx) {
    const unsigned G = gridDim.x * gridDim.y * gridDim.z;
    unsigned sum, cnt, mine, sp = 0u;
    for (;;) {
        sum = 0u; cnt = 0u; mine = 0u;
#pragma unroll
        for (unsigned j = 0; j < 16; ++j) { const unsigned c = xb_ld(&bar[XB_XCNT(j)]); sum += c; cnt += (c > 0u) ? 1u : 0u; mine = (j == x) ? c : mine; }
        if (sum == G) break;
        __builtin_amdgcn_s_sleep(1);
        if ((++sp & 255u) == 0u) { if (xb_ld(&bar[XB_TMO])) break; if (sp > XB_SPIN_CAP) { atomicAdd(&bar[XB_TMO], 1u); break; } }
    }
    nloc = mine > 0u ? mine : 1u; nx = cnt > 0u ? cnt : 1u;
}
__device__ __forceinline__ void xcd_barrier(const XcdBarrier& b) {
    asm volatile("s_waitcnt vmcnt(0)" ::: "memory");
    __syncthreads();
    if (threadIdx.x == 0) {
        unsigned* bar = b.bar;
        __builtin_amdgcn_s_waitcnt(0);
        unsigned nloc = b.st[0], nx = b.st[1];
        if (nloc == 0u) { xcd_barrier_complete(bar, b.x, nloc, nx); b.st[0] = nloc; b.st[1] = nx; }
        const unsigned old = xb_add(&bar[XB_XSUB(b.x)], 1u);
        const unsigned gen = old / nloc;
        if (old + 1u == (gen + 1u) * nloc) {
            __builtin_amdgcn_fence(__ATOMIC_RELEASE, "agent");
            asm volatile("s_waitcnt vmcnt(0)" ::: "memory");
            const unsigned og = xb_add(&bar[XB_TOP], 1u);
            const unsigned tg = og / nx;
            if (og + 1u == (tg + 1u) * nx) xb_add(&bar[XB_TOPGEN], 1u);
            else XB_SPIN(xb_ld(&bar[XB_TOPGEN]) == tg, bar);
            __builtin_amdgcn_fence(__ATOMIC_ACQUIRE, "agent");
            xb_add(&bar[XB_XGEN(b.x)], 1u);
            asm volatile("s_waitcnt vmcnt(0)" ::: "memory");
        } else {
            XB_SPIN(xb_ld(&bar[XB_XGEN(b.x)]) == gen, bar);
            __builtin_amdgcn_fence(__ATOMIC_ACQUIRE, "agent");
            asm volatile("s_waitcnt vmcnt(0)" ::: "memory");
        }
    }
    __syncthreads();
}

struct Args { const float* in[16]; float* out; unsigned char* ws; int ph_lo, ph_hi; };
struct Frame {
    LAS unsigned char* lds;
    int tid, lane, wave, vcu, G;
};
__device__ __forceinline__ float wave_sum(float v) {
#pragma unroll
    for (int o = 1; o < 64; o <<= 1) v += __shfl_xor(v, o);
    return v;
}

__device__ __forceinline__ void p0_transpose_item(const float* W, int K, int N, bf16* WT, int mode, LAS bf16* scr, int item, int lane) {
    const int nblk = N / 64, kb = item / nblk, nb = item - kb * nblk, k0 = 64 * kb, n0 = 64 * nb;
    const int nq = lane & 15, kp = lane >> 4;
    const float* src = W + (size_t)(k0 + 2 * kp) * N + n0 + 4 * nq;
    f32x4 a[8], b[8];
#pragma unroll
    for (int j = 0; j < 8; ++j) { a[j] = *(const f32x4*)(src + (size_t)(8 * j) * N); b[j] = *(const f32x4*)(src + (size_t)(8 * j + 1) * N); }
#pragma unroll
    for (int j = 0; j < 8; ++j) {
#pragma unroll
        for (int i = 0; i < 4; ++i) *(LAS unsigned*)(scr + (4 * nq + i) * 72 + 8 * j + 2 * kp) = pk2(a[j][i], b[j][i]); }
    asm volatile("s_waitcnt lgkmcnt(0)" ::: "memory");
    const int c = lane & 7, nr = lane >> 3;
    const int drow0 = (mode == 0) ? n0 : ((n0 >> 7) * 256 + (n0 & 127) + (mode == 2 ? 128 : 0));
#pragma unroll
    for (int j = 0; j < 8; ++j) { const int n = nr + 8 * j; const v4u o = *(const LAS v4u*)(scr + n * 72 + 8 * c); const int dr = drow0 + n;
        *(v4u*)(WT + ((size_t)(dr >> 8) * (K >> 6) + (k0 >> 6)) * 16384 + (size_t)(dr & 255) * 64 + 8 * c) = o; }
    asm volatile("s_waitcnt lgkmcnt(0)" ::: "memory");
}

template <bool OUT_F32>
__device__ __forceinline__ void rmsnorm_rows(const Frame& F, const float* src0, const float* src1, int split_row, const float* g, bf16* outb, float* outf) {
    const int gw = F.vcu * NWAVES + F.wave, NGW = F.G * NWAVES;
    for (int m = gw; m < MT; m += NGW) {
        const float* xrow = (m < split_row) ? src0 + (size_t)m * DM : src1 + (size_t)(m - split_row) * DM;
        const f32x4* xr = (const f32x4*)xrow + F.lane;
        f32x4 v[16]; float s = 0.f;
#pragma unroll
        for (int j = 0; j < 16; ++j) { v[j] = xr[64 * j]; s += (v[j].x * v[j].x + v[j].y * v[j].y) + (v[j].z * v[j].z + v[j].w * v[j].w); }
        const float r = 1.0f / sqrtf(wave_sum(s) * (1.0f / DM) + EPS);
        const f32x4* gr = (const f32x4*)g + F.lane;
        if (OUT_F32) { f32x4* o = (f32x4*)(outf + (size_t)m * DM) + F.lane;
#pragma unroll
            for (int j = 0; j < 16; ++j) { const f32x4 gg = gr[64 * j]; o[64 * j] = v[j] * r * gg; } }
        else { v2u* o = (v2u*)(outb + (size_t)m * DM) + F.lane;
#pragma unroll
            for (int j = 0; j < 16; ++j) { const f32x4 gg = gr[64 * j]; const f32x4 y = v[j] * r * gg; v2u w; w.x = pk2(y.x, y.y); w.y = pk2(y.z, y.w); o[64 * j] = w; } }
    }
}

__device__ __forceinline__ void p0_prologue(const Frame& F, const Args& a) {
    unsigned char* ws = a.ws;
    LAS bf16* scr = (LAS bf16*)(F.lds + RING_OFF + F.wave * 16384);
    const int gw = F.vcu * NWAVES + F.wave, NGW = F.G * NWAVES;
    constexpr int I_IN = (DM / 64) * (2 * DM / 64), I_O = (DM / 64) * (DM / 64), I_GU = (DM / 64) * (DFF / 64), I_D = (DFF / 64) * (DM / 64);
    constexpr int NITEMS = I_IN + 2 * I_O + 4 * I_GU + 2 * I_D;
    for (int it = gw; it < NITEMS; it += NGW) {
        int r = it;
        if (r < I_IN) { p0_transpose_item(a.in[3], DM, 2 * DM, (bf16*)(ws + WS_WIN), 0, scr, r, F.lane); continue; } r -= I_IN;
        if (r < I_O) { p0_transpose_item(a.in[8], DM, DM, (bf16*)(ws + WS_WOA), 0, scr, r, F.lane); continue; } r -= I_O;
        if (r < I_O) { p0_transpose_item(a.in[10], DM, DM, (bf16*)(ws + WS_WOB), 0, scr, r, F.lane); continue; } r -= I_O;
        if (r < 4 * I_GU) { const int q = r / I_GU, l = q >> 1, up = q & 1; r -= q * I_GU;
            p0_transpose_item(a.in[up ? 13 : 12] + (size_t)l * DM * DFF, DM, DFF, (bf16*)(ws + WS_WGU + (size_t)l * WGU_BYTES), 1 + up, scr, r, F.lane); continue; } r -= 4 * I_GU;
        { const int l = r / I_D; r -= l * I_D; p0_transpose_item(a.in[14] + (size_t)l * DFF * DM, DFF, DM, (bf16*)(ws + WS_WD + (size_t)l * WD_BYTES), 0, scr, r, F.lane); }
    }
    const int gt = (F.vcu * NWAVES + F.wave) * 64 + F.lane, NGT = F.G * NWAVES * 64;
    for (int i = gt; i < NHEAD * CHUNK * CHUNK / 8; i += NGT) { const f32x4 x0 = ((const f32x4*)a.in[6])[2 * i], x1 = ((const f32x4*)a.in[6])[2 * i + 1];
        v4u o; o.x = pk2(x0.x, x0.y); o.y = pk2(x0.z, x0.w); o.z = pk2(x1.x, x1.y); o.w = pk2(x1.z, x1.w); ((v4u*)(ws + WS_WSB))[i] = o; }
    for (int i = gt; i < 1024 * 512 / 8; i += NGT) { const int r = i >> 6, c0 = (i & 63) * 8, k2 = r & 511, cs = r >> 9; float v[8];
#pragma unroll
        for (int j = 0; j < 8; ++j) { const int idx = (k2 * (c0 + j)) & 511; float sn, cn; sincospif((float)idx * (2.0f / 512.0f), &sn, &cn); v[j] = cs ? sn : cn; }
        v4u o; o.x = pk2(v[0], v[1]); o.y = pk2(v[2], v[3]); o.z = pk2(v[4], v[5]); o.w = pk2(v[6], v[7]); ((v4u*)(ws + WS_D512))[i] = o; }
#pragma unroll
    for (int which = 0; which < 2; ++which) {
        const int S = which ? S_S : S_P, KP = S + 256, kp8 = KP / 8; bf16* AD = (bf16*)(ws + (which ? WS_ADS : WS_ADP)); const float inv = 2.0f / (float)S;
        for (int i = gt; i < S * kp8; i += NGT) { const int k1 = i / kp8, k0 = (i - k1 * kp8) * 8; float v[8];
#pragma unroll
            for (int j = 0; j < 8; ++j) { const int k = k0 + j; int sidx; bool is_cos, zero = false;
                if (k <= S / 2) { sidx = k; is_cos = true; } else if (k < S / 2 + 256) { sidx = 0; is_cos = true; zero = true; } else { sidx = k - (S / 2 + 256) + 1; is_cos = false; zero = sidx > S / 2 - 1; }
                const int idx = (k1 * sidx) & (S - 1); float sn, cn; sincospif((float)idx * inv, &sn, &cn); v[j] = zero ? 0.0f : (is_cos ? cn : -sn); }
            v4u o; o.x = pk2(v[0], v[1]); o.y = pk2(v[2], v[3]); o.z = pk2(v[4], v[5]); o.w = pk2(v[6], v[7]);
            *(v4u*)(AD + (size_t)k1 * KP + k0) = o; }
    }
    rmsnorm_rows<false>(F, a.in[0], a.in[1], M_P, a.in[2], (bf16*)(ws + WS_XN), nullptr);
}

__device__ __forceinline__ void vstats_phase(const Frame& F, const Args& a) {
    const bf16* Z = (const bf16*)(a.ws + WS_BIG); float* STATS = (float*)(a.ws + WS_CTL) + CW_STATS;
    const int gw = F.vcu * NWAVES + F.wave, NGW = F.G * NWAVES, lane = F.lane;
    for (int m0 = gw; m0 < MT; m0 += 2 * NGW) {
        v4u raw[2][8]; float mean[2], rstd[2];
#pragma unroll
        for (int q = 0; q < 2; ++q) { const int m = m0 + q * NGW; const v4u* vr = (const v4u*)(Z + (size_t)(m < MT ? m : m0) * (2 * DM) + DM) + lane;
#pragma unroll
            for (int j = 0; j < 8; ++j) raw[q][j] = vr[64 * j]; }
#pragma unroll
        for (int q = 0; q < 2; ++q) { float s = 0.f;
#pragma unroll
            for (int j = 0; j < 8; ++j) s += (bf_lo(raw[q][j].x) + bf_hi(raw[q][j].x)) + (bf_lo(raw[q][j].y) + bf_hi(raw[q][j].y)) + (bf_lo(raw[q][j].z) + bf_hi(raw[q][j].z)) + (bf_lo(raw[q][j].w) + bf_hi(raw[q][j].w));
            mean[q] = wave_sum(s) * (1.0f / DM); }
#pragma unroll
        for (int q = 0; q < 2; ++q) { float s2 = 0.f;
#pragma unroll
            for (int j = 0; j < 8; ++j) {
#pragma unroll
                for (int e = 0; e < 4; ++e) { const float d0 = bf_lo(raw[q][j][e]) - mean[q], d1 = bf_hi(raw[q][j][e]) - mean[q]; s2 += d0 * d0 + d1 * d1; } }
            rstd[q] = 1.0f / sqrtf(wave_sum(s2) * (1.0f / DM) + EPS); }
#pragma unroll
        for (int q = 0; q < 2; ++q) { const int m = m0 + q * NGW; if (m < MT && lane == 0) { STATS[2 * m] = mean[q]; STATS[2 * m + 1] = rstd[q]; } }
    }
}
__device__ __forceinline__ void gate_phase(const Frame& F, const Args& a) {
    const bf16* Z = (const bf16*)(a.ws + WS_BIG); bf16* Gout = (bf16*)(a.ws + WS_XN); const bf16* WSB = (const bf16*)(a.ws + WS_WSB);
    const float* STATS = (const float*)(a.ws + WS_CTL) + CW_STATS;
    const float* ln_g = a.in[4]; const float* ln_b = a.in[5]; const float* b_s = a.in[7];
    constexpr int VP = 136, VT_BYTES = 128 * VP * 2;
    const int t = F.tid, lane = F.lane, w = F.wave, fr = lane & 15, fq = lane >> 4;
    const int q = t >> 2, cs = (t & 3) * 32, p = 16 * w + fr;
    for (int unit = F.vcu; unit < (MT / CHUNK) * 4; unit += F.G) {
        const int chunk = unit >> 2, hg = unit & 3, r0 = chunk * CHUNK;
        const float mean = STATS[2 * (r0 + q)], rstd = STATS[2 * (r0 + q) + 1];
        v4u raw[4];
        { const v4u* src = (const v4u*)(Z + (size_t)(r0 + q) * (2 * DM) + DM + (hg * 8) * HD + cs);
#pragma unroll
          for (int i = 0; i < 4; ++i) raw[i] = src[i]; }
#pragma unroll
        for (int hh = 0; hh < 8; ++hh) { const int h = hg * 8 + hh;
            LAS bf16* Vt = (LAS bf16*)(F.lds + RING_OFF + (hh & 1) * VT_BYTES);
            { const f32x4* gp = (const f32x4*)(ln_g + h * HD + cs); const f32x4* bp = (const f32x4*)(ln_b + h * HD + cs);
#pragma unroll
              for (int i = 0; i < 4; ++i) { const v4u rw = raw[i]; const f32x4 g0 = gp[2 * i], g1 = gp[2 * i + 1], b0 = bp[2 * i], b1 = bp[2 * i + 1];
                  float y[8];
                  y[0] = (bf_lo(rw.x) - mean) * rstd * g0.x + b0.x; y[1] = (bf_hi(rw.x) - mean) * rstd * g0.y + b0.y; y[2] = (bf_lo(rw.y) - mean) * rstd * g0.z + b0.z; y[3] = (bf_hi(rw.y) - mean) * rstd * g0.w + b0.w;
                  y[4] = (bf_lo(rw.z) - mean) * rstd * g1.x + b1.x; y[5] = (bf_hi(rw.z) - mean) * rstd * g1.y + b1.y; y[6] = (bf_lo(rw.w) - mean) * rstd * g1.z + b1.z; y[7] = (bf_hi(rw.w) - mean) * rstd * g1.w + b1.w;
#pragma unroll
                  for (int e = 0; e < 8; e += 2) { const unsigned pk = pk2(y[e], y[e + 1]); Vt[(cs + 8 * i + e) * VP + q] = (bf16)(pk & 0xffffu); Vt[(cs + 8 * i + e + 1) * VP + q] = (bf16)(pk >> 16); } } }
            if (hh < 7) { const v4u* src = (const v4u*)(Z + (size_t)(r0 + q) * (2 * DM) + DM + (h + 1) * HD + cs);
#pragma unroll
                for (int i = 0; i < 4; ++i) raw[i] = src[i]; }
            bf16x8 af[4];
#pragma unroll
            for (int ks = 0; ks < 4; ++ks) af[ks] = *(const bf16x8*)(WSB + ((size_t)h * CHUNK + p) * CHUNK + 32 * ks + 8 * fq);
            v2u uu[8];
#pragma unroll
            for (int ct = 0; ct < 8; ++ct) uu[ct] = *(const v2u*)(Z + (size_t)(r0 + p) * (2 * DM) + h * HD + 16 * ct + 4 * fq);
            const float bias = b_s[h * CHUNK + p];
            __syncthreads();
#pragma unroll
            for (int ct = 0; ct < 8; ++ct) { f32x4 acc = (f32x4){0.f, 0.f, 0.f, 0.f};
#pragma unroll
                for (int ks = 0; ks < 4; ++ks) { const bf16x8 bfr = *(const LAS bf16x8*)(Vt + (16 * ct + fr) * VP + 32 * ks + 8 * fq); acc = __builtin_amdgcn_mfma_f32_16x16x32_bf16(bfr, af[ks], acc, 0, 0, 0); }
                v2u o; o.x = pk2(bf_lo(uu[ct].x) * (acc[0] + bias), bf_hi(uu[ct].x) * (acc[1] + bias)); o.y = pk2(bf_lo(uu[ct].y) * (acc[2] + bias), bf_hi(uu[ct].y) * (acc[3] + bias));
                *(v2u*)(Gout + (size_t)(r0 + p) * DM + h * HD + 16 * ct + 4 * fq) = o; }
        }
        __syncthreads();
    }
}

__device__ __forceinline__ void fold_norm_phase(const Frame& F, const float* x, const float* g, bf16* FOLD) {
    const int gw = F.vcu * NWAVES + F.wave, NGW = F.G * NWAVES;
    constexpr int IT_P = S_P / 2 + 1, IT_S = S_S / 2 + 1, NIT = NB_P * IT_P + NB_S * IT_S;
    const f32x4* gr = (const f32x4*)g + F.lane;
    for (int it = gw; it < NIT; it += NGW) {
        int b, s, S, KP; size_t tok0, frow0;
        if (it < NB_P * IT_P) { b = it / IT_P; s = it - b * IT_P; S = S_P; KP = KP_P; tok0 = (size_t)b * S_P; frow0 = (size_t)b * KP_P; }
        else { const int r = it - NB_P * IT_P; b = r / IT_S; s = r - b * IT_S; S = S_S; KP = KP_S; tok0 = (size_t)M_P + (size_t)b * S_S; frow0 = (size_t)NB_P * KP_P + (size_t)b * KP_S; }
        const bool single = (s == 0) || (s == S / 2);
        const f32x4* xa = (const f32x4*)(x + (tok0 + s) * DM) + F.lane; const f32x4* xb = (const f32x4*)(x + (tok0 + (single ? s : S - s)) * DM) + F.lane;
        f32x4 va[16], vb[16]; float sa = 0.f, sb = 0.f;
#pragma unroll
        for (int j = 0; j < 16; ++j) { va[j] = xa[64 * j]; vb[j] = xb[64 * j]; sa += (va[j].x * va[j].x + va[j].y * va[j].y) + (va[j].z * va[j].z + va[j].w * va[j].w); sb += (vb[j].x * vb[j].x + vb[j].y * vb[j].y) + (vb[j].z * vb[j].z + vb[j].w * vb[j].w); }
        const float ra = 1.0f / sqrtf(wave_sum(sa) * (1.0f / DM) + EPS), rb = single ? 0.0f : 1.0f / sqrtf(wave_sum(sb) * (1.0f / DM) + EPS);
        v2u* oe = (v2u*)(FOLD + (frow0 + s) * DM) + F.lane; v2u* oo = (v2u*)(FOLD + (frow0 + S / 2 + 256 + (s - 1)) * DM) + F.lane;
#pragma unroll
        for (int j = 0; j < 16; ++j) { const f32x4 gg = gr[64 * j]; const f32x4 ya = va[j] * ra * gg, yb = vb[j] * rb * gg; const f32x4 he = ya + yb, ho = ya - yb;
            v2u w; w.x = pk2(he.x, he.y); w.y = pk2(he.z, he.w); oe[64 * j] = w;
            if (!single) { v2u q; q.x = pk2(ho.x, ho.y); q.y = pk2(ho.z, ho.w); oo[64 * j] = q; } }
    }
    for (int it = gw; it < (NB_P + NB_S) * 256; it += NGW) { const int bb = it >> 8, k = it & 255; int S; size_t frow0;
        if (bb < NB_P) { S = S_P; frow0 = (size_t)bb * KP_P; } else { S = S_S; frow0 = (size_t)NB_P * KP_P + (size_t)(bb - NB_P) * KP_S; }
        const size_t row = frow0 + (k < 255 ? (size_t)(S / 2 + 1 + k) : (size_t)(S + 255));
        v2u* o = (v2u*)(FOLD + row * DM) + F.lane; v2u z; z.x = 0u; z.y = 0u;
#pragma unroll
        for (int j = 0; j < 16; ++j) o[64 * j] = z; }
}

__global__ void __launch_bounds__(NWAVES * 64, 2) mega_fwd(Args args) {
    extern __shared__ __attribute__((aligned(16))) unsigned char lds_raw[];
    Frame F;
    F.lds = (LAS unsigned char*)lds_raw;
    F.tid = threadIdx.x; F.lane = F.tid & 63; F.wave = __builtin_amdgcn_readfirstlane(F.tid >> 6);
    F.G = gridDim.x; { const int bx = blockIdx.x; F.vcu = (F.G % 8 == 0) ? (bx % 8) * (F.G / 8) + bx / 8 : bx; }
    unsigned char* ws = args.ws;
    gu32* ctl = (gu32*)(ws + WS_CTL);
    volatile LAS unsigned* MISC = (volatile LAS unsigned*)(F.lds + MISC_OFF);
    for (int u = F.tid; u < (LDS_BYTES - LDSCTL_OFF) / 4; u += NWAVES * 64) ((LAS unsigned*)(F.lds + LDSCTL_OFF))[u] = 0u;
    __syncthreads();
    XcdBarrier bar; bar.bar = (unsigned*)(ctl + CW_BAR); bar.x = 0; bar.st = nullptr;
    if (N_LAUNCHES == 1) bar = xcd_barrier_post((unsigned*)(ctl + CW_BAR), MISC + 8);
    const int lo = args.ph_lo, hi = args.ph_hi;
#define IN(k) (lo <= (k) && (k) < hi)
#define SEAM(k) do { if (IN(k) && IN((k) + 1)) xcd_barrier(bar); } while (0)
    LAS unsigned char* ring = F.lds + RING_OFF;
    const int bx = (int)blockIdx.x;
    bf16* XN = (bf16*)(ws + WS_XN); bf16* BIG = (bf16*)(ws + WS_BIG);
    const float* xp = args.in[0]; const float* xs = args.in[1];

    if (IN(0)) { p0_prologue(F, args); } SEAM(0);
    if (IN(1)) { pg8::Gemm g{XN, (const bf16*)(ws + WS_WIN), DM, 64, DM, 0, 0, (size_t)256 * DM, (size_t)256 * DM, 128, 32768}; pg8::Order S; S.init(MT / 256, 2 * DM / 256, 1, F.G, bx);
        pg8::EpiGelu E{BIG, 2 * DM}; pg8::gemm_phase<pg8::EpiGelu>(ring, g, S, E); } SEAM(1);
    if (IN(2)) { vstats_phase(F, args); xcd_barrier(bar); gate_phase(F, args); } SEAM(2);
    if (IN(3)) { pg8::Gemm g{XN, (const bf16*)(ws + WS_WOA), DM, 64, DM, 0, 0, (size_t)256 * DM, (size_t)256 * DM, 128, 32768}; pg8::Order S; S.init(MT / 256, DM / 256, 1, F.G, bx);
        pg8::EpiRes E{xp, xs, M_P / 256, args.out, DM}; pg8::gemm_phase<pg8::EpiRes>(ring, g, S, E); } SEAM(3);
    if (IN(4)) { rmsnorm_rows<false>(F, args.out, args.out, MT, args.in[11], XN, nullptr); } SEAM(4);
    if (IN(5)) { pg8::Gemm g{XN, (const bf16*)(ws + WS_WGU), DM, 64, DM, 0, 0, (size_t)256 * DM, (size_t)256 * DM, 128, 32768}; pg8::Order S; S.init(MT / 256, 2 * DFF / 256, 1, F.G, bx);
        pg8::EpiSwiglu E{BIG, DFF}; pg8::gemm_phase<pg8::EpiSwiglu>(ring, g, S, E); } SEAM(5);
    if (IN(6)) { pg8::Gemm g{BIG, (const bf16*)(ws + WS_WD), DFF, 64, DFF, 0, 0, (size_t)256 * DFF, (size_t)256 * DFF, 128, 32768}; pg8::Order S; S.init(MT / 256, DM / 256, 1, F.G, bx);
        pg8::EpiRes E{args.out, args.out, 1 << 30, args.out, DM}; pg8::gemm_phase<pg8::EpiRes>(ring, g, S, E); } SEAM(6);
    bf16* FOLD = BIG; bf16* TB = (bf16*)(ws + WS_BIG + BIG_T_OFF);
    const pg8::FoldGeom fgeo{NB_P * FT_P, FT_P, FT_S, KP_P, KP_S, NB_P};
    if (IN(7)) { fold_norm_phase(F, args.out, args.in[9], FOLD); } SEAM(7);
    if (IN(8)) { pg8::Gemm g{(const bf16*)(ws + WS_D512), FOLD, GD, DM, GD, 0, (size_t)GD, (size_t)256 * GD, (size_t)256 * DM, 128, 128}; pg8::OrderFour S; S.init(NFT, NGRP, F.G, bx, fgeo);
        pg8::EpiFourA E{TB, fgeo}; pg8::gemm_phase<pg8::EpiFourA, pg8::OrderFour>(ring, g, S, E); } SEAM(8);
    if (IN(9)) {
        { pg8::Gemm g{(const bf16*)(ws + WS_ADP), TB, KP_P, KP_P, KP_P, 0, (size_t)DM * KP_P, (size_t)256 * KP_P, (size_t)256 * KP_P, 128, 128}; pg8::Order S; S.init(S_P / 256, DM / 256, NB_P, F.G, bx);
          pg8::EpiScale E{XN, DM, 0.0009765625f  , S_P}; pg8::gemm_phase<pg8::EpiScale>(ring, g, S, E); }
        { pg8::Gemm g{(const bf16*)(ws + WS_ADS), TB + (size_t)NB_P * DM * KP_P, KP_S, KP_S, KP_S, 0, (size_t)DM * KP_S, (size_t)256 * KP_S, (size_t)256 * KP_S, 128, 128}; pg8::Order S; S.init(S_S / 256, DM / 256, NB_S, F.G, bx);
          pg8::EpiScale E{XN + (size_t)M_P * DM, DM, 0.00069053396600248784f  , S_S}; pg8::gemm_phase<pg8::EpiScale>(ring, g, S, E); }
    } SEAM(9);
    if (IN(10)) { pg8::Gemm g{XN, (const bf16*)(ws + WS_WOB), DM, 64, DM, 0, 0, (size_t)256 * DM, (size_t)256 * DM, 128, 32768}; pg8::Order S; S.init(MT / 256, DM / 256, 1, F.G, bx);
        pg8::EpiRes E{args.out, args.out, 1 << 30, args.out, DM}; pg8::gemm_phase<pg8::EpiRes>(ring, g, S, E); } SEAM(10);
    if (IN(11)) { rmsnorm_rows<false>(F, args.out, args.out, MT, args.in[11] + DM, XN, nullptr); } SEAM(11);
    if (IN(12)) { pg8::Gemm g{XN, (const bf16*)(ws + WS_WGU + WGU_BYTES), DM, 64, DM, 0, 0, (size_t)256 * DM, (size_t)256 * DM, 128, 32768}; pg8::Order S; S.init(MT / 256, 2 * DFF / 256, 1, F.G, bx);
        pg8::EpiSwiglu E{BIG, DFF}; pg8::gemm_phase<pg8::EpiSwiglu>(ring, g, S, E); } SEAM(12);
    if (IN(13)) { pg8::Gemm g{BIG, (const bf16*)(ws + WS_WD + WD_BYTES), DFF, 64, DFF, 0, 0, (size_t)256 * DFF, (size_t)256 * DFF, 128, 32768}; pg8::Order S; S.init(MT / 256, DM / 256, 1, F.G, bx);
        pg8::EpiRes E{args.out, args.out, 1 << 30, args.out, DM}; pg8::gemm_phase<pg8::EpiRes>(ring, g, S, E); } SEAM(13);
    if (IN(14)) {
        rmsnorm_rows<true>(F, args.out, args.out, MT, args.in[15], nullptr, args.out);
        if (N_LAUNCHES == 1 && __hip_atomic_load((unsigned*)(ctl + CW_BAR) + XB_TMO, RLX_AGENT) != 0u) {
            const int gw = F.vcu * NWAVES + F.wave, NGW = F.G * NWAVES; const float q = __builtin_nanf("");
            for (int m = gw; m < MT; m += NGW) { f32x4* o = (f32x4*)(args.out + (size_t)m * DM) + F.lane;
#pragma unroll
                for (int j = 0; j < 16; ++j) o[64 * j] = (f32x4){q, q, q, q}; } }
    }
#undef IN
#undef SEAM
}

extern "C" void kernel_launch(void* const* d_in, const int* in_sizes, int n_in, void* d_out, int out_size, void* d_ws, size_t ws_size, hipStream_t stream) {
    static int grid = 0;
    if (grid == 0) {
        if (n_in != 16 || in_sizes[0] != M_P * DM || in_sizes[1] != M_S * DM || out_size != MT * DM || ws_size < WS_END) {
            fprintf(stderr, "kernel_launch: unexpected shapes (n_in %d, out %d, ws %zu, need %zu); nothing launched\n", n_in, out_size, ws_size, (size_t)WS_END); grid = -1; return; }
        int dev = 0, cus = 0, per_cu = 0;
        if (hipGetDevice(&dev) != hipSuccess || hipDeviceGetAttribute(&cus, hipDeviceAttributeMultiprocessorCount, dev) != hipSuccess) { grid = -1; return; }
        if (hipFuncSetAttribute((const void*)mega_fwd, hipFuncAttributeMaxDynamicSharedMemorySize, LDS_BYTES) != hipSuccess) { fprintf(stderr, "kernel_launch: hipFuncSetAttribute failed\n"); grid = -1; return; }
        if (hipOccupancyMaxActiveBlocksPerMultiprocessor(&per_cu, (const void*)mega_fwd, NWAVES * 64, LDS_BYTES) != hipSuccess || per_cu < 1)
            fprintf(stderr, "kernel_launch: note: occupancy query reports %d workgroups per CU\n", per_cu);
        (void)hipGetLastError();
        grid = cus;
    }
    if (grid < 0) return;
    if (hipMemsetAsync((char*)d_ws + WS_CTL, 0, CTL_ZERO_BYTES, stream) != hipSuccess) return;
    Args a{};
    for (int i = 0; i < 16; ++i) a.in[i] = (const float*)d_in[i];
    a.out = (float*)d_out; a.ws = (unsigned char*)d_ws;
    for (int li = 0; li < N_LAUNCHES; ++li) {
        a.ph_lo = (N_LAUNCHES == 1) ? 0 : li; a.ph_hi = (N_LAUNCHES == 1) ? N_PHASES : li + 1;
        hipLaunchKernelGGL(mega_fwd, dim3(grid), dim3(NWAVES * 64), LDS_BYTES, stream, a);
        const hipError_t le = hipPeekAtLastError();
        if (le != hipSuccess) { fprintf(stderr, "kernel_launch: launch %d failed: %s\n", li, hipGetErrorName(le)); break; }
    }
}
```

```cpp
#include <hip/hip_runtime.h>
#include <cstdio>
#include <cstdint>

#ifndef MK_N_LAUNCHES
#define MK_N_LAUNCHES 1
#endif

namespace pg8 {
#define PG8_LAS __attribute__((address_space(3)))
typedef unsigned short bf16_t;
typedef short bf16x8 __attribute__((ext_vector_type(8)));
typedef float f32x4 __attribute__((ext_vector_type(4)));
typedef float f32x2 __attribute__((ext_vector_type(2)));
typedef unsigned u32x4 __attribute__((ext_vector_type(4)));
constexpr int BM = 256, BK = 64, HALF = 128, HTB = HALF * BK * 2  , STAGE_BYTES = 8 * HTB, NXCD = 8, WGM = 8;

__host__ __device__ __forceinline__ int lds_byte(int r, int c) { const int st = (r >> 4) * 2 + (c >> 5), rr = r & 15, cc = c & 31, ob = rr * 64 + cc * 2; return st * 1024 + (ob ^ (((ob >> 9) & 1) << 5)); }
__host__ __device__ __forceinline__ void stage_rc(int b, int& R, int& C) { const int st = b / 1024, sb = b % 1024, swz = sb ^ (((sb >> 9) & 1) << 5); R = (st >> 1) * 16 + swz / 64; C = (st & 1) * 32 + (swz % 64) / 2; }
__host__ __device__ __forceinline__ int perm32(int rho) { const int n = rho >> 4, i = rho & 15; return 8 * (i >> 2) + 4 * n + (i & 3); }

__host__ __device__ __forceinline__ size_t toff(int r, int c, int kt) { return ((size_t)(r >> 8) * kt + (c >> 6)) * 16384 + (size_t)(r & 255) * 64 + (c & 63); }

struct Unit { int pm, pn, aux; };
struct Gemm { const bf16_t* A; const bf16_t* Bt; int lda, ldb, K; size_t a_aux, b_aux; size_t a_tile, b_tile; int ksA, ksB; };

struct Order {
    int nM, nN, per, nwg, G, c;
    __device__ __forceinline__ void init(int nM_, int nN_, int nAux_, int G_, int c_) { nM = nM_; nN = nN_; per = nM_ * nN_; nwg = per * nAux_; G = G_; c = c_; }
    __device__ __forceinline__ bool next(int i, Unit& u) const {
        const long L = (long)i * G + c; if (L >= nwg) return false;
        int wgid = (int)L; { const int q = nwg / NXCD, r = nwg % NXCD, xcd = wgid % NXCD, off = wgid / NXCD; wgid = (xcd < r ? xcd * (q + 1) : r * (q + 1) + (xcd - r) * q) + off; }
        u.aux = wgid / per; const int w = wgid - u.aux * per;
        const int nig = WGM * nN, gid = w / nig, fm = gid * WGM, gsz = (nM - fm) < WGM ? (nM - fm) : WGM;
        u.pm = fm + ((w % nig) % gsz); u.pn = (w % nig) / gsz; return true;
    }
};

__device__ __forceinline__ unsigned cvt_pk_bf16(float lo, float hi) { unsigned r; asm volatile("v_cvt_pk_bf16_f32 %0, %1, %2" : "=v"(r) : "v"(lo), "v"(hi)); return r; }
__device__ __forceinline__ u32x4 pack8(const f32x4 v0, const f32x4 v1) { u32x4 w; w.x = cvt_pk_bf16(v0[0], v0[1]); w.y = cvt_pk_bf16(v0[2], v0[3]); w.z = cvt_pk_bf16(v1[0], v1[1]); w.w = cvt_pk_bf16(v1[2], v1[3]); return w; }
__device__ __forceinline__ f32x2 gelu_tanh_pk(f32x2 x) {
    const f32x2 x2 = x * x, u = x * (x2 * 0.0356774081f + 0.7978845608f), t = u * (-2.885390082f);
    f32x2 e; e.x = __builtin_amdgcn_exp2f(t.x); e.y = __builtin_amdgcn_exp2f(t.y);
    const f32x2 d = e + 1.0f; f32x2 r; r.x = __builtin_amdgcn_rcpf(d.x); r.y = __builtin_amdgcn_rcpf(d.y);
    return x * r;
}
__device__ __forceinline__ f32x4 gelu4(const f32x4 v) { const f32x2 a = gelu_tanh_pk((f32x2){v[0], v[1]}), b = gelu_tanh_pk((f32x2){v[2], v[3]}); return (f32x4){a.x, a.y, b.x, b.y}; }
__device__ __forceinline__ f32x2 swiglu_pk(f32x2 g, f32x2 u) {
    const f32x2 t = g * (-1.4426950409f); f32x2 e; e.x = __builtin_amdgcn_exp2f(t.x); e.y = __builtin_amdgcn_exp2f(t.y);
    const f32x2 d = e + 1.0f; f32x2 r; r.x = __builtin_amdgcn_rcpf(d.x); r.y = __builtin_amdgcn_rcpf(d.y);
    return g * r * u;
}
__device__ __forceinline__ f32x4 swiglu4(const f32x4 g, const f32x4 u) { const f32x2 a = swiglu_pk((f32x2){g[0], g[1]}, (f32x2){u[0], u[1]}), b = swiglu_pk((f32x2){g[2], g[3]}, (f32x2){u[2], u[3]}); return (f32x4){a.x, a.y, b.x, b.y}; }

struct EpiGelu {
    static constexpr bool PERM = true;
    bf16_t* O; int ldc;
    __device__ __forceinline__ void operator()(const f32x4 (&acc)[2][2][4][2], const Unit& u, int wr, int wc, int fr, int fq) const {
        const int row0 = u.pm * BM + wr * 64 + fr, col0 = u.pn * BM + wc * 32 + 8 * fq;
#pragma unroll
        for (int ai = 0; ai < 2; ++ai)
#pragma unroll
            for (int m = 0; m < 4; ++m) { bf16_t* rowp = O + (size_t)(row0 + ai * HALF + m * 16) * ldc + col0;
#pragma unroll
                for (int bj = 0; bj < 2; ++bj) *(u32x4*)(rowp + bj * HALF) = pack8(gelu4(acc[ai][bj][m][0]), gelu4(acc[ai][bj][m][1])); }
    }
};
struct EpiSwiglu {
    static constexpr bool PERM = true;
    bf16_t* O; int ldc;
    __device__ __forceinline__ void operator()(const f32x4 (&acc)[2][2][4][2], const Unit& u, int wr, int wc, int fr, int fq) const {
        const int row0 = u.pm * BM + wr * 64 + fr, col0 = u.pn * HALF + wc * 32 + 8 * fq;
#pragma unroll
        for (int ai = 0; ai < 2; ++ai)
#pragma unroll
            for (int m = 0; m < 4; ++m) { bf16_t* rowp = O + toff(row0 + ai * HALF + m * 16, col0, ldc >> 6);
                *(u32x4*)rowp = pack8(swiglu4(acc[ai][0][m][0], acc[ai][1][m][0]), swiglu4(acc[ai][0][m][1], acc[ai][1][m][1])); }
    }
};
struct EpiScale {
    static constexpr bool PERM = true;
    bf16_t* O; int ldc; float scale; int aux_rows;
    __device__ __forceinline__ void operator()(const f32x4 (&acc)[2][2][4][2], const Unit& u, int wr, int wc, int fr, int fq) const {
        const int row0 = u.aux * aux_rows + u.pm * BM + wr * 64 + fr, col0 = u.pn * BM + wc * 32 + 8 * fq;
#pragma unroll
        for (int ai = 0; ai < 2; ++ai)
#pragma unroll
            for (int m = 0; m < 4; ++m) {
#pragma unroll
                for (int bj = 0; bj < 2; ++bj) *(u32x4*)(O + toff(row0 + ai * HALF + m * 16, col0 + bj * HALF, ldc >> 6)) = pack8(acc[ai][bj][m][0] * scale, acc[ai][bj][m][1] * scale); }
    }
};
struct EpiRes {
    static constexpr bool PERM = false;
    const float* base0; const float* base1; int split_pm; float* out; int ldc;
    __device__ __forceinline__ void operator()(const f32x4 (&acc)[2][2][4][2], const Unit& u, int wr, int wc, int fr, int fq) const {
        const float* bp = (u.pm < split_pm) ? base0 + (size_t)u.pm * BM * ldc : base1 + (size_t)(u.pm - split_pm) * BM * ldc;
        float* op = out + (size_t)u.pm * BM * ldc;
        const int col0 = u.pn * BM + wc * 32 + 4 * fq;
#pragma unroll
        for (int ai = 0; ai < 2; ++ai)
#pragma unroll
            for (int m = 0; m < 4; ++m) { const size_t off = (size_t)(ai * HALF + wr * 64 + m * 16 + fr) * ldc + col0;
#pragma unroll
                for (int bj = 0; bj < 2; ++bj)
#pragma unroll
                    for (int n = 0; n < 2; ++n) { const f32x4 bs = *(const f32x4*)(bp + off + bj * HALF + n * 16); *(f32x4*)(op + off + bj * HALF + n * 16) = bs + acc[ai][bj][m][n]; }
                asm volatile("" ::: "memory"); }
    }
};
struct FoldGeom { int ntp, tpp, tps, kpp, kps, nbp; };
struct OrderFour {
    int ntile, nwg, G, c; FoldGeom fg;
    __device__ __forceinline__ void init(int ntile_, int ngrp, int G_, int c_, FoldGeom fg_) { ntile = ntile_; nwg = ntile_ * 2 * ngrp; G = G_; c = c_; fg = fg_; }
    __device__ __forceinline__ bool next(int i, Unit& u) const {
        const long L = (long)i * G + c; if (L >= nwg) return false;
        int wgid = (int)L; { const int q = nwg / NXCD, r = nwg % NXCD, xcd = wgid % NXCD, off = wgid / NXCD; wgid = (xcd < r ? xcd * (q + 1) : r * (q + 1) + (xcd - r) * q) + off; }
        const int per = ntile * 2; u.aux = wgid / per; const int w = wgid - u.aux * per, ft = w >> 1;
        const bool ho = (ft < fg.ntp) ? ((ft % fg.tpp) >= (fg.tpp + 1) / 2) : (((ft - fg.ntp) % fg.tps) >= (fg.tps + 1) / 2);
        u.pm = (w & 1) + (ho ? 2 : 0); u.pn = ft; return true;
    }
};
struct EpiFourA {
    static constexpr bool PERM = true;
    bf16_t* T; FoldGeom fg;
    __device__ __forceinline__ void operator()(const f32x4 (&acc)[2][2][4][2], const Unit& u, int wr, int wc, int fr, int fq) const {
        const int ft = u.pn; int KP, tt; size_t tb;
        if (ft < fg.ntp) { const int b = ft / fg.tpp; tt = ft - b * fg.tpp; KP = fg.kpp; tb = (size_t)b * 4096 * fg.kpp; }
        else { const int b = (ft - fg.ntp) / fg.tps; tt = (ft - fg.ntp) - b * fg.tps; KP = fg.kps; tb = (size_t)fg.nbp * 4096 * fg.kpp + (size_t)b * 4096 * fg.kps; }
        const int j0 = tt * BM + wc * 32 + 8 * fq, r0 = u.pm * BM + wr * 64 + fr;
        bf16_t* base = T + tb;
#pragma unroll
        for (int ai = 0; ai < 2; ++ai)
#pragma unroll
            for (int m = 0; m < 4; ++m) { const int ch = u.aux * 512 + ((r0 + ai * HALF + m * 16) & 511);
#pragma unroll
                for (int bj = 0; bj < 2; ++bj) *(u32x4*)(base + toff(ch, j0 + bj * HALF, KP >> 6)) = pack8(acc[ai][bj][m][0], acc[ai][bj][m][1]); }
    }
};

template <class Epi, class Sched = Order, bool ALIGN_EPI = true>
__device__ __forceinline__ void gemm_phase(PG8_LAS unsigned char* lds, const Gemm g, const Sched& S, const Epi& E) {
    const int tid = threadIdx.x, wid = __builtin_amdgcn_readfirstlane(tid >> 6), lane = tid & 63, wr = wid >> 2, wc = wid & 3, fr = lane & 15, fq = lane >> 4;
    const int K = g.K, nt = K / BK;
    unsigned voffA[2], voffB[2];
#pragma unroll
    for (int i = 0; i < 2; ++i) { int R, C; stage_rc(tid * 16 + i * 8192, R, C); const int Rb = Epi::PERM ? ((R & ~31) + perm32(R & 31)) : R;
        voffA[i] = (unsigned)(R * g.lda + C) * 2u; voffB[i] = (unsigned)(Rb * g.ldb + C) * 2u; }
    const size_t ksA = (size_t)g.ksA, ksB = (size_t)g.ksB;
    const size_t hsA = (size_t)HALF * g.lda * 2, hsB = (size_t)HALF * g.ldb * 2;
    const unsigned ldsw = (unsigned)wid * 1024u;
    const int aoff = lds_byte(wr * 64 + fr, fq * 8), boff = lds_byte(wc * 32 + fr, fq * 8);
#define PG8_SA(b, h) (((b) * 2 + (h)) * HTB)
#define PG8_SB(b, h) ((4 + (b) * 2 + (h)) * HTB)
#define PG8_STAGE(bufoff, gbase, voff) do { _Pragma("unroll") for (int _i = 0; _i < 2; ++_i) \
        __builtin_amdgcn_global_load_lds((const unsigned*)((const char*)(gbase) + (voff)[_i]), (PG8_LAS unsigned*)(lds + (bufoff) + ldsw + _i * 8192), 16, 0, 0); } while (0)
#define PG8_LDA(dst, b, h) do { _Pragma("unroll") for (int m = 0; m < 4; ++m) _Pragma("unroll") for (int k = 0; k < 2; ++k) dst[m][k] = *(const PG8_LAS bf16x8*)(lds + PG8_SA(b, h) + aoff + m * 2048 + k * 1024); } while (0)
#define PG8_LDB(dst, b, h) do { _Pragma("unroll") for (int n = 0; n < 2; ++n) _Pragma("unroll") for (int k = 0; k < 2; ++k) dst[n][k] = *(const PG8_LAS bf16x8*)(lds + PG8_SB(b, h) + boff + n * 2048 + k * 1024); } while (0)
#define PG8_MMA(ai, bj, At, Bt) do { __builtin_amdgcn_s_setprio(1); _Pragma("unroll") for (int m = 0; m < 4; ++m) _Pragma("unroll") for (int n = 0; n < 2; ++n) _Pragma("unroll") for (int k = 0; k < 2; ++k) \
        acc[ai][bj][m][n] = __builtin_amdgcn_mfma_f32_16x16x32_bf16(Bt[n][k], At[m][k], acc[ai][bj][m][n], 0, 0, 0); __builtin_amdgcn_s_setprio(0); } while (0)
#define PG8_WAIT_V(n) asm volatile("s_waitcnt vmcnt(" #n ")" ::: "memory")
#define PG8_WAIT_L(n) asm volatile("s_waitcnt lgkmcnt(" #n ")" ::: "memory")
#define PG8_BAR __builtin_amdgcn_s_barrier()
#define PG8_SCHED __builtin_amdgcn_sched_barrier(0)
#define PG8_APTR(u) ((const char*)g.A + ((size_t)(u).pm * g.a_tile + (size_t)(u).aux * g.a_aux) * 2)
#define PG8_BPTR(u) ((const char*)g.Bt + ((size_t)(u).pn * g.b_tile + (size_t)(u).aux * g.b_aux) * 2)
    Unit cur, nxt; int ui = 0;
    if (!S.next(0, cur)) return;
    f32x4 acc[2][2][4][2];
#pragma unroll
    for (int a = 0; a < 2; ++a)
#pragma unroll
        for (int b = 0; b < 2; ++b)
#pragma unroll
            for (int m = 0; m < 4; ++m)
#pragma unroll
                for (int n = 0; n < 2; ++n) acc[a][b][m][n] = (f32x4){0.f, 0.f, 0.f, 0.f};
    bf16x8 At[4][2], B0[2][2], B1[2][2];
    const char* cA = PG8_APTR(cur); const char* cB = PG8_BPTR(cur);
    PG8_STAGE(PG8_SB(0, 0), cB, voffB); PG8_STAGE(PG8_SB(0, 1), cB + hsB, voffB); PG8_STAGE(PG8_SA(0, 0), cA, voffA); PG8_STAGE(PG8_SA(0, 1), cA + hsA, voffA);
    if (wr == 1) PG8_BAR;
    PG8_WAIT_V(2); PG8_BAR;
    PG8_STAGE(PG8_SB(1, 0), cB + ksB, voffB); PG8_STAGE(PG8_SA(1, 0), cA + ksA, voffA); PG8_STAGE(PG8_SB(1, 1), cB + hsB + ksB, voffB);
    PG8_WAIT_V(6); PG8_BAR;
    for (;;) {
        const bool has_next = S.next(ui + 1, nxt);
        const char* nA = has_next ? PG8_APTR(nxt) : cA; const char* nB = has_next ? PG8_BPTR(nxt) : cB;
        for (int t = 0; t < nt; t += 2) {
            const bool last = (t == nt - 2);
            const char* a1 = cA + (size_t)(t + 1) * ksA;
            const char* a2 = last ? nA : cA + (size_t)(t + 2) * ksA; const char* b2 = last ? nB : cB + (size_t)(t + 2) * ksB;
            const char* a3 = a2 + ksA; const char* b3 = b2 + ksB;
            PG8_LDB(B0, 0, 0); PG8_LDB(B1, 0, 1); PG8_SCHED; PG8_LDA(At, 0, 0); PG8_STAGE(PG8_SA(1, 1), a1 + hsA, voffA);
            PG8_WAIT_V(8); PG8_WAIT_L(0); PG8_BAR; PG8_MMA(0, 0, At, B0); PG8_MMA(0, 1, At, B1); PG8_BAR; PG8_SCHED;
            PG8_LDA(At, 0, 1); PG8_STAGE(PG8_SB(0, 0), b2, voffB); PG8_STAGE(PG8_SB(0, 1), b2 + hsB, voffB); PG8_STAGE(PG8_SA(0, 0), a2, voffA);
            PG8_WAIT_V(8); PG8_WAIT_L(0); PG8_BAR; PG8_MMA(1, 0, At, B0); PG8_MMA(1, 1, At, B1); PG8_BAR; PG8_SCHED;
            PG8_LDB(B0, 1, 0); PG8_LDB(B1, 1, 1); PG8_SCHED; PG8_LDA(At, 1, 0); PG8_STAGE(PG8_SA(0, 1), a2 + hsA, voffA);
            PG8_WAIT_V(8); PG8_WAIT_L(0); PG8_BAR; PG8_MMA(0, 0, At, B0); PG8_MMA(0, 1, At, B1); PG8_BAR; PG8_SCHED;
            PG8_LDA(At, 1, 1); PG8_STAGE(PG8_SB(1, 0), b3, voffB); PG8_STAGE(PG8_SB(1, 1), b3 + hsB, voffB); PG8_STAGE(PG8_SA(1, 0), a3, voffA);
            PG8_WAIT_V(8); PG8_WAIT_L(0); PG8_BAR; PG8_MMA(1, 0, At, B0); PG8_MMA(1, 1, At, B1); PG8_BAR; PG8_SCHED;
        }
        if constexpr (ALIGN_EPI) { if (wr == 0) PG8_BAR; }
        E(acc, cur, wr, wc, fr, fq);
        if (!has_next) break;
#pragma unroll
        for (int a = 0; a < 2; ++a)
#pragma unroll
            for (int b = 0; b < 2; ++b)
#pragma unroll
                for (int m = 0; m < 4; ++m)
#pragma unroll
                    for (int n = 0; n < 2; ++n) acc[a][b][m][n] = (f32x4){0.f, 0.f, 0.f, 0.f};
        cur = nxt; cA = nA; cB = nB; ++ui;
        if constexpr (ALIGN_EPI) { if (wr == 1) PG8_BAR; }
    }
    PG8_WAIT_V(0);
    if constexpr (!ALIGN_EPI) { if (wr == 0) PG8_BAR; }
    PG8_BAR;
#undef PG8_SA
#undef PG8_SB
#undef PG8_STAGE
#undef PG8_LDA
#undef PG8_LDB
#undef PG8_MMA
#undef PG8_WAIT_V
#undef PG8_WAIT_L
#undef PG8_BAR
#undef PG8_SCHED
#undef PG8_APTR
#undef PG8_BPTR
}
}

constexpr int NWAVES = 8;
constexpr int DM = 4096, DFF = 11008, NB_P = 8, S_P = 2048, NB_S = 2, S_S = 4096;
constexpr int M_P = NB_P * S_P, M_S = NB_S * S_S, MT = M_P + M_S;
constexpr int NHEAD = 32, CHUNK = 128, HD = 128, NGRP = 8, GD = 512;
constexpr float EPS = 1e-6f;
constexpr int KP_P = S_P + 256, KP_S = S_S + 256;
constexpr int FT_P = KP_P / 256, FT_S = KP_S / 256, NFT = NB_P * FT_P + NB_S * FT_S;
constexpr int N_PHASES = 15;
constexpr int N_LAUNCHES = MK_N_LAUNCHES;
static_assert(N_LAUNCHES == 1, "one launch only (phase 2 carries a grid barrier of its own)");

constexpr size_t MiB = 1u << 20;
constexpr size_t WS_CTL = 0, CTL_ZERO_BYTES = 1 * MiB;
constexpr size_t WS_WIN = 1 * MiB;
constexpr size_t WS_WOA = WS_WIN + (size_t)2 * DM * DM * 2;
constexpr size_t WS_WOB = WS_WOA + (size_t)DM * DM * 2;
constexpr size_t WS_WGU = WS_WOB + (size_t)DM * DM * 2;
constexpr size_t WGU_BYTES = (size_t)2 * DFF * DM * 2;
constexpr size_t WS_WD = WS_WGU + 2 * WGU_BYTES;
constexpr size_t WD_BYTES = (size_t)DM * DFF * 2;
constexpr size_t WS_WSB = WS_WD + 2 * WD_BYTES;
constexpr size_t WS_D512 = WS_WSB + 1 * MiB;
constexpr size_t WS_ADP = WS_D512 + 1 * MiB;
constexpr size_t WS_ADS = WS_ADP + (size_t)S_P * 2 * S_P * 2;
constexpr size_t WS_XN = WS_ADS + (size_t)S_S * 2 * S_S * 2;
constexpr size_t WS_BIG = WS_XN + (size_t)MT * DM * 2;
constexpr size_t BIG_T_OFF = 256 * MiB;
static_assert((size_t)NFT * 256 * DM * 2 <= BIG_T_OFF && BIG_T_OFF + ((size_t)NB_P * KP_P + (size_t)NB_S * KP_S) * DM * 2 <= (size_t)MT * DFF * 2, "fold + T inside BIG");
constexpr size_t WS_END = WS_BIG + (size_t)MT * DFF * 2;
static_assert(WS_WSB % 256 == 0 && WS_XN % 256 == 0 && WS_BIG % 256 == 0, "alignment");
constexpr int CW_TMO = 0;
constexpr int CW_BAR = 4096;
constexpr int CW_STATS = 16384;
static_assert((size_t)(CW_STATS + 2 * MT) * 4 <= CTL_ZERO_BYTES, "control region");

constexpr int RING_OFF = 0, RING_BYTES = 131072;
constexpr int LDSCTL_OFF = RING_BYTES, MISC_OFF = LDSCTL_OFF + 320;
constexpr int LDS_BYTES = 147456;

#define GAS __attribute__((address_space(1)))
#define LAS __attribute__((address_space(3)))
typedef unsigned short bf16;
typedef unsigned v4u __attribute__((ext_vector_type(4)));
typedef unsigned v2u __attribute__((ext_vector_type(2)));
typedef float f32x4 __attribute__((ext_vector_type(4)));
typedef short bf16x8 __attribute__((ext_vector_type(8)));
typedef GAS unsigned gu32;
#define RLX_AGENT __ATOMIC_RELAXED, __HIP_MEMORY_SCOPE_AGENT
__device__ __forceinline__ unsigned pk2(float lo, float hi) { return pg8::cvt_pk_bf16(lo, hi); }
__device__ __forceinline__ float bf_lo(unsigned w) { return __uint_as_float(w << 16); }
__device__ __forceinline__ float bf_hi(unsigned w) { return __uint_as_float(w & 0xffff0000u); }

#define XB_TMO      128
#define XB_XCNT(j)  (256  + 64 * (j))
#define XB_XSUB(j)  (1280 + 64 * (j))
#define XB_XGEN(j)  (2304 + 64 * (j))
#define XB_TOP      3328
#define XB_TOPGEN   3392
#define XCD_BAR_WORDS 3456
#define XB_SPIN_CAP (1u << 18)

__device__ __forceinline__ unsigned xb_ld(unsigned* p)              { return __hip_atomic_load(p, __ATOMIC_RELAXED, __HIP_MEMORY_SCOPE_AGENT); }
__device__ __forceinline__ unsigned xb_add(unsigned* p, unsigned v) { return __hip_atomic_fetch_add(p, v, __ATOMIC_RELAXED, __HIP_MEMORY_SCOPE_AGENT); }
__device__ __forceinline__ unsigned xb_xcc_id() { return (unsigned)__builtin_amdgcn_s_getreg((3 << 11) | 20) & 0xFu; }
#define XB_SPIN(cond, bar) do { unsigned _sp = 0; while (cond) { __builtin_amdgcn_s_sleep(1); \
    if ((++_sp & 255u) == 0u) { if (xb_ld(&(bar)[XB_TMO])) break; if (_sp > XB_SPIN_CAP) { atomicAdd(&(bar)[XB_TMO], 1u); break; } } } } while (0)

struct XcdBarrier {
    unsigned* bar; unsigned x;
    volatile LAS unsigned* st;
};
__device__ __forceinline__ XcdBarrier xcd_barrier_post(unsigned* bar, volatile LAS unsigned* st) {
    XcdBarrier b; b.bar = bar; b.x = xb_xcc_id(); b.st = st;
    if (threadIdx.x == 0) (void)xb_add(&bar[XB_XCNT(b.x)], 1u);
    return b;
}
__device__ __forceinline__ void xcd_barrier_complete(unsigned* bar, unsigned x, unsigned& nloc, unsigned& nx) {
    const unsigned G = gridDim.x * gridDim.y * gridDim.z;
    unsigned sum, cnt, mine, sp = 0u;
    for (;;) {
        sum = 0u; cnt = 0u; mine = 0u;
#pragma unroll
        for (unsigned j = 0; j < 16; ++j) { const unsigned c = xb_ld(&bar[XB_XCNT(j)]); sum += c; cnt += (c > 0u) ? 1u : 0u; mine = (j == x) ? c : mine; }
        if (sum == G) break;
        __builtin_amdgcn_s_sleep(1);
        if ((++sp & 255u) == 0u) { if (xb_ld(&bar[XB_TMO])) break; if (sp > XB_SPIN_CAP) { atomicAdd(&bar[XB_TMO], 1u); break; } }
    }
    nloc = mine > 0u ? mine : 1u; nx = cnt > 0u ? cnt : 1u;
}
__device__ __forceinline__ void xcd_barrier(const XcdBarrier& b) {
    asm volatile("s_waitcnt vmcnt(0)" ::: "memory");
    __syncthreads();
    if (threadIdx.x == 0) {
        unsigned* bar = b.bar;
        __builtin_amdgcn_s_waitcnt(0);
        unsigned nloc = b.st[0], nx = b.st[1];
        if (nloc == 0u) { xcd_barrier_complete(bar, b.x, nloc, nx); b.st[0] = nloc; b.st[1] = nx; }
        const unsigned old = xb_add(&bar[XB_XSUB(b.x)], 1u);
        const unsigned gen = old / nloc;
        if (old + 1u == (gen + 1u) * nloc) {
            __builtin_amdgcn_fence(__ATOMIC_RELEASE, "agent");
            asm volatile("s_waitcnt vmcnt(0)" ::: "memory");
            const unsigned og = xb_add(&bar[XB_TOP], 1u);
            const unsigned tg = og / nx;
            if (og + 1u == (tg + 1u) * nx) xb_add(&bar[XB_TOPGEN], 1u);
            else XB_SPIN(xb_ld(&bar[XB_TOPGEN]) == tg, bar);
            __builtin_amdgcn_fence(__ATOMIC_ACQUIRE, "agent");
            xb_add(&bar[XB_XGEN(b.x)], 1u);
            asm volatile("s_waitcnt vmcnt(0)" ::: "memory");
        } else {
            XB_SPIN(xb_ld(&bar[XB_XGEN(b.x)]) == gen, bar);
            __builtin_amdgcn_fence(__ATOMIC_ACQUIRE, "agent");
            asm volatile("s_waitcnt vmcnt(0)" ::: "memory");
        }
    }
    __syncthreads();
}

struct Args { const float* in[16]; float* out; unsigned char* ws; int ph_lo, ph_hi; };
struct Frame {
    LAS unsigned char* lds;
    int tid, lane, wave, vcu, G;
};
__device__ __forceinline__ float wave_sum(float v) {
#pragma unroll
    for (int o = 1; o < 64; o <<= 1) v += __shfl_xor(v, o);
    return v;
}

__device__ __forceinline__ void p0_transpose_item(const float* W, int K, int N, bf16* WT, int mode, LAS bf16* scr, int item, int lane) {
    const int nblk = N / 64, kb = item / nblk, nb = item - kb * nblk, k0 = 64 * kb, n0 = 64 * nb;
    const int nq = lane & 15, kp = lane >> 4;
    const float* src = W + (size_t)(k0 + 2 * kp) * N + n0 + 4 * nq;
    f32x4 a[8], b[8];
#pragma unroll
    for (int j = 0; j < 8; ++j) { a[j] = *(const f32x4*)(src + (size_t)(8 * j) * N); b[j] = *(const f32x4*)(src + (size_t)(8 * j + 1) * N); }
#pragma unroll
    for (int j = 0; j < 8; ++j) {
#pragma unroll
        for (int i = 0; i < 4; ++i) *(LAS unsigned*)(scr + (4 * nq + i) * 72 + 8 * j + 2 * kp) = pk2(a[j][i], b[j][i]); }
    asm volatile("s_waitcnt lgkmcnt(0)" ::: "memory");
    const int c = lane & 7, nr = lane >> 3;
    const int drow0 = (mode == 0) ? n0 : ((n0 >> 7) * 256 + (n0 & 127) + (mode == 2 ? 128 : 0));
#pragma unroll
    for (int j = 0; j < 8; ++j) { const int n = nr + 8 * j; const v4u o = *(const LAS v4u*)(scr + n * 72 + 8 * c); const int dr = drow0 + n;
        *(v4u*)(WT + ((size_t)(dr >> 8) * (K >> 6) + (k0 >> 6)) * 16384 + (size_t)(dr & 255) * 64 + 8 * c) = o; }
    asm volatile("s_waitcnt lgkmcnt(0)" ::: "memory");
}

template <bool OUT_F32>
__device__ __forceinline__ void rmsnorm_rows(const Frame& F, const float* src0, const float* src1, int split_row, const float* g, bf16* outb, float* outf) {
    const int gw = F.vcu * NWAVES + F.wave, NGW = F.G * NWAVES;
    for (int m = gw; m < MT; m += NGW) {
        const float* xrow = (m < split_row) ? src0 + (size_t)m * DM : src1 + (size_t)(m - split_row) * DM;
        const f32x4* xr = (const f32x4*)xrow + F.lane;
        f32x4 v[16]; float s = 0.f;
#pragma unroll
        for (int j = 0; j < 16; ++j) { v[j] = xr[64 * j]; s += (v[j].x * v[j].x + v[j].y * v[j].y) + (v[j].z * v[j].z + v[j].w * v[j].w); }
        const float r = 1.0f / sqrtf(wave_sum(s) * (1.0f / DM) + EPS);
        const f32x4* gr = (const f32x4*)g + F.lane;
        if (OUT_F32) { f32x4* o = (f32x4*)(outf + (size_t)m * DM) + F.lane;
#pragma unroll
            for (int j = 0; j < 16; ++j) { const f32x4 gg = gr[64 * j]; o[64 * j] = v[j] * r * gg; } }
        else {
#pragma unroll
            for (int j = 0; j < 16; ++j) { const f32x4 gg = gr[64 * j]; const f32x4 y = v[j] * r * gg; v2u w; w.x = pk2(y.x, y.y); w.y = pk2(y.z, y.w); *(v2u*)(outb + pg8::toff(m, 4 * F.lane + 256 * j, DM / 64)) = w; } }
    }
}

__device__ __forceinline__ void p0_prologue(const Frame& F, const Args& a) {
    unsigned char* ws = a.ws;
    LAS bf16* scr = (LAS bf16*)(F.lds + RING_OFF + F.wave * 16384);
    const int gw = F.vcu * NWAVES + F.wave, NGW = F.G * NWAVES;
    constexpr int I_IN = (DM / 64) * (2 * DM / 64), I_O = (DM / 64) * (DM / 64), I_GU = (DM / 64) * (DFF / 64), I_D = (DFF / 64) * (DM / 64);
    constexpr int NITEMS = I_IN + 2 * I_O + 4 * I_GU + 2 * I_D;
    for (int it = gw; it < NITEMS; it += NGW) {
        int r = it;
        if (r < I_IN) { p0_transpose_item(a.in[3], DM, 2 * DM, (bf16*)(ws + WS_WIN), 0, scr, r, F.lane); continue; } r -= I_IN;
        if (r < I_O) { p0_transpose_item(a.in[8], DM, DM, (bf16*)(ws + WS_WOA), 0, scr, r, F.lane); continue; } r -= I_O;
        if (r < I_O) { p0_transpose_item(a.in[10], DM, DM, (bf16*)(ws + WS_WOB), 0, scr, r, F.lane); continue; } r -= I_O;
        if (r < 4 * I_GU) { const int q = r / I_GU, l = q >> 1, up = q & 1; r -= q * I_GU;
            p0_transpose_item(a.in[up ? 13 : 12] + (size_t)l * DM * DFF, DM, DFF, (bf16*)(ws + WS_WGU + (size_t)l * WGU_BYTES), 1 + up, scr, r, F.lane); continue; } r -= 4 * I_GU;
        { const int l = r / I_D; r -= l * I_D; p0_transpose_item(a.in[14] + (size_t)l * DFF * DM, DFF, DM, (bf16*)(ws + WS_WD + (size_t)l * WD_BYTES), 0, scr, r, F.lane); }
    }
    const int gt = (F.vcu * NWAVES + F.wave) * 64 + F.lane, NGT = F.G * NWAVES * 64;
    for (int i = gt; i < NHEAD * CHUNK * CHUNK / 8; i += NGT) { const f32x4 x0 = ((const f32x4*)a.in[6])[2 * i], x1 = ((const f32x4*)a.in[6])[2 * i + 1];
        v4u o; o.x = pk2(x0.x, x0.y); o.y = pk2(x0.z, x0.w); o.z = pk2(x1.x, x1.y); o.w = pk2(x1.z, x1.w); ((v4u*)(ws + WS_WSB))[i] = o; }
    for (int i = gt; i < 1024 * 512 / 8; i += NGT) { const int r = i >> 6, c0 = (i & 63) * 8, k2 = r & 511, cs = r >> 9; float v[8];
#pragma unroll
        for (int j = 0; j < 8; ++j) { const int idx = (k2 * (c0 + j)) & 511; float sn, cn; sincospif((float)idx * (2.0f / 512.0f), &sn, &cn); v[j] = cs ? sn : cn; }
        v4u o; o.x = pk2(v[0], v[1]); o.y = pk2(v[2], v[3]); o.z = pk2(v[4], v[5]); o.w = pk2(v[6], v[7]); ((v4u*)(ws + WS_D512))[i] = o; }
#pragma unroll
    for (int which = 0; which < 2; ++which) {
        const int S = which ? S_S : S_P, KP = S + 256, kp8 = KP / 8; bf16* AD = (bf16*)(ws + (which ? WS_ADS : WS_ADP)); const float inv = 2.0f / (float)S;
        for (int i = gt; i < S * kp8; i += NGT) { const int k1 = i / kp8, k0 = (i - k1 * kp8) * 8; float v[8];
#pragma unroll
            for (int j = 0; j < 8; ++j) { const int k = k0 + j; int sidx; bool is_cos, zero = false;
                if (k <= S / 2) { sidx = k; is_cos = true; } else if (k < S / 2 + 256) { sidx = 0; is_cos = true; zero = true; } else { sidx = k - (S / 2 + 256) + 1; is_cos = false; zero = sidx > S / 2 - 1; }
                const int idx = (k1 * sidx) & (S - 1); float sn, cn; sincospif((float)idx * inv, &sn, &cn); v[j] = zero ? 0.0f : (is_cos ? cn : -sn); }
            v4u o; o.x = pk2(v[0], v[1]); o.y = pk2(v[2], v[3]); o.z = pk2(v[4], v[5]); o.w = pk2(v[6], v[7]);
            *(v4u*)(AD + pg8::toff(k1, k0, KP >> 6)) = o; }
    }
    rmsnorm_rows<false>(F, a.in[0], a.in[1], M_P, a.in[2], (bf16*)(ws + WS_XN), nullptr);
}

__device__ __forceinline__ void vstats_phase(const Frame& F, const Args& a) {
    const bf16* Z = (const bf16*)(a.ws + WS_BIG); float* STATS = (float*)(a.ws + WS_CTL) + CW_STATS;
    const int gw = F.vcu * NWAVES + F.wave, NGW = F.G * NWAVES, lane = F.lane;
    for (int m0 = gw; m0 < MT; m0 += 2 * NGW) {
        v4u raw[2][8]; float mean[2], rstd[2];
#pragma unroll
        for (int q = 0; q < 2; ++q) { const int m = m0 + q * NGW; const v4u* vr = (const v4u*)(Z + (size_t)(m < MT ? m : m0) * (2 * DM) + DM) + lane;
#pragma unroll
            for (int j = 0; j < 8; ++j) raw[q][j] = vr[64 * j]; }
#pragma unroll
        for (int q = 0; q < 2; ++q) { float s = 0.f;
#pragma unroll
            for (int j = 0; j < 8; ++j) s += (bf_lo(raw[q][j].x) + bf_hi(raw[q][j].x)) + (bf_lo(raw[q][j].y) + bf_hi(raw[q][j].y)) + (bf_lo(raw[q][j].z) + bf_hi(raw[q][j].z)) + (bf_lo(raw[q][j].w) + bf_hi(raw[q][j].w));
            mean[q] = wave_sum(s) * (1.0f / DM); }
#pragma unroll
        for (int q = 0; q < 2; ++q) { float s2 = 0.f;
#pragma unroll
            for (int j = 0; j < 8; ++j) {
#pragma unroll
                for (int e = 0; e < 4; ++e) { const float d0 = bf_lo(raw[q][j][e]) - mean[q], d1 = bf_hi(raw[q][j][e]) - mean[q]; s2 += d0 * d0 + d1 * d1; } }
            rstd[q] = 1.0f / sqrtf(wave_sum(s2) * (1.0f / DM) + EPS); }
#pragma unroll
        for (int q = 0; q < 2; ++q) { const int m = m0 + q * NGW; if (m < MT && lane == 0) { STATS[2 * m] = mean[q]; STATS[2 * m + 1] = rstd[q]; } }
    }
}
__device__ __forceinline__ void gate_phase(const Frame& F, const Args& a) {
    const bf16* Z = (const bf16*)(a.ws + WS_BIG); bf16* Gout = (bf16*)(a.ws + WS_XN); const bf16* WSB = (const bf16*)(a.ws + WS_WSB);
    const float* STATS = (const float*)(a.ws + WS_CTL) + CW_STATS;
    const float* ln_g = a.in[4]; const float* ln_b = a.in[5]; const float* b_s = a.in[7];
    constexpr int VP = 136, VT_BYTES = 128 * VP * 2;
    const int t = F.tid, lane = F.lane, w = F.wave, fr = lane & 15, fq = lane >> 4;
    const int q = t >> 2, cs = (t & 3) * 32, p = 16 * w + fr;
    for (int unit = F.vcu; unit < (MT / CHUNK) * 4; unit += F.G) {
        const int chunk = unit >> 2, hg = unit & 3, r0 = chunk * CHUNK;
        const float mean = STATS[2 * (r0 + q)], rstd = STATS[2 * (r0 + q) + 1];
        v4u raw[4];
        { const v4u* src = (const v4u*)(Z + (size_t)(r0 + q) * (2 * DM) + DM + (hg * 8) * HD + cs);
#pragma unroll
          for (int i = 0; i < 4; ++i) raw[i] = src[i]; }
#pragma unroll
        for (int hh = 0; hh < 8; ++hh) { const int h = hg * 8 + hh;
            LAS bf16* Vt = (LAS bf16*)(F.lds + RING_OFF + (hh & 1) * VT_BYTES);
            { const f32x4* gp = (const f32x4*)(ln_g + h * HD + cs); const f32x4* bp = (const f32x4*)(ln_b + h * HD + cs);
#pragma unroll
              for (int i = 0; i < 4; ++i) { const v4u rw = raw[i]; const f32x4 g0 = gp[2 * i], g1 = gp[2 * i + 1], b0 = bp[2 * i], b1 = bp[2 * i + 1];
                  float y[8];
                  y[0] = (bf_lo(rw.x) - mean) * rstd * g0.x + b0.x; y[1] = (bf_hi(rw.x) - mean) * rstd * g0.y + b0.y; y[2] = (bf_lo(rw.y) - mean) * rstd * g0.z + b0.z; y[3] = (bf_hi(rw.y) - mean) * rstd * g0.w + b0.w;
                  y[4] = (bf_lo(rw.z) - mean) * rstd * g1.x + b1.x; y[5] = (bf_hi(rw.z) - mean) * rstd * g1.y + b1.y; y[6] = (bf_lo(rw.w) - mean) * rstd * g1.z + b1.z; y[7] = (bf_hi(rw.w) - mean) * rstd * g1.w + b1.w;
#pragma unroll
                  for (int e = 0; e < 8; e += 2) { const unsigned pk = pk2(y[e], y[e + 1]); Vt[(cs + 8 * i + e) * VP + q] = (bf16)(pk & 0xffffu); Vt[(cs + 8 * i + e + 1) * VP + q] = (bf16)(pk >> 16); } } }
            if (hh < 7) { const v4u* src = (const v4u*)(Z + (size_t)(r0 + q) * (2 * DM) + DM + (h + 1) * HD + cs);
#pragma unroll
                for (int i = 0; i < 4; ++i) raw[i] = src[i]; }
            bf16x8 af[4];
#pragma unroll
            for (int ks = 0; ks < 4; ++ks) af[ks] = *(const bf16x8*)(WSB + ((size_t)h * CHUNK + p) * CHUNK + 32 * ks + 8 * fq);
            v2u uu[8];
#pragma unroll
            for (int ct = 0; ct < 8; ++ct) uu[ct] = *(const v2u*)(Z + (size_t)(r0 + p) * (2 * DM) + h * HD + 16 * ct + 4 * fq);
            const float bias = b_s[h * CHUNK + p];
            __syncthreads();
#pragma unroll
            for (int ct = 0; ct < 8; ++ct) { f32x4 acc = (f32x4){0.f, 0.f, 0.f, 0.f};
#pragma unroll
                for (int ks = 0; ks < 4; ++ks) { const bf16x8 bfr = *(const LAS bf16x8*)(Vt + (16 * ct + fr) * VP + 32 * ks + 8 * fq); acc = __builtin_amdgcn_mfma_f32_16x16x32_bf16(bfr, af[ks], acc, 0, 0, 0); }
                v2u o; o.x = pk2(bf_lo(uu[ct].x) * (acc[0] + bias), bf_hi(uu[ct].x) * (acc[1] + bias)); o.y = pk2(bf_lo(uu[ct].y) * (acc[2] + bias), bf_hi(uu[ct].y) * (acc[3] + bias));
                *(v2u*)(Gout + pg8::toff(r0 + p, h * HD + 16 * ct + 4 * fq, DM / 64)) = o; }
        }
        __syncthreads();
    }
}

__device__ __forceinline__ void fold_norm_phase(const Frame& F, const float* x, const float* g, bf16* FOLD) {
    const int gw = F.vcu * NWAVES + F.wave, NGW = F.G * NWAVES;
    constexpr int IT_P = S_P / 2 + 1, IT_S = S_S / 2 + 1, NIT = NB_P * IT_P + NB_S * IT_S;
    const f32x4* gr = (const f32x4*)g + F.lane;
    for (int it = gw; it < NIT; it += NGW) {
        int b, s, S, KP; size_t tok0, frow0;
        if (it < NB_P * IT_P) { b = it / IT_P; s = it - b * IT_P; S = S_P; KP = KP_P; tok0 = (size_t)b * S_P; frow0 = (size_t)b * KP_P; }
        else { const int r = it - NB_P * IT_P; b = r / IT_S; s = r - b * IT_S; S = S_S; KP = KP_S; tok0 = (size_t)M_P + (size_t)b * S_S; frow0 = (size_t)NB_P * KP_P + (size_t)b * KP_S; }
        const bool single = (s == 0) || (s == S / 2);
        const f32x4* xa = (const f32x4*)(x + (tok0 + s) * DM) + F.lane; const f32x4* xb = (const f32x4*)(x + (tok0 + (single ? s : S - s)) * DM) + F.lane;
        f32x4 va[16], vb[16]; float sa = 0.f, sb = 0.f;
#pragma unroll
        for (int j = 0; j < 16; ++j) { va[j] = xa[64 * j]; vb[j] = xb[64 * j]; sa += (va[j].x * va[j].x + va[j].y * va[j].y) + (va[j].z * va[j].z + va[j].w * va[j].w); sb += (vb[j].x * vb[j].x + vb[j].y * vb[j].y) + (vb[j].z * vb[j].z + vb[j].w * vb[j].w); }
        const float ra = 1.0f / sqrtf(wave_sum(sa) * (1.0f / DM) + EPS), rb = single ? 0.0f : 1.0f / sqrtf(wave_sum(sb) * (1.0f / DM) + EPS);
        const int re = (int)(frow0 + s), ro = (int)(frow0 + S / 2 + 256 + (s - 1));
#pragma unroll
        for (int j = 0; j < 16; ++j) { const f32x4 gg = gr[64 * j]; const f32x4 ya = va[j] * ra * gg, yb = vb[j] * rb * gg; const f32x4 he = ya + yb, ho = ya - yb;
            v2u w; w.x = pk2(he.x, he.y); w.y = pk2(he.z, he.w); *(v2u*)(FOLD + pg8::toff(re, 4 * F.lane + 256 * j, DM / 64)) = w;
            if (!single) { v2u q; q.x = pk2(ho.x, ho.y); q.y = pk2(ho.z, ho.w); *(v2u*)(FOLD + pg8::toff(ro, 4 * F.lane + 256 * j, DM / 64)) = q; } }
    }
    for (int it = gw; it < (NB_P + NB_S) * 256; it += NGW) { const int bb = it >> 8, k = it & 255; int S; size_t frow0;
        if (bb < NB_P) { S = S_P; frow0 = (size_t)bb * KP_P; } else { S = S_S; frow0 = (size_t)NB_P * KP_P + (size_t)(bb - NB_P) * KP_S; }
        const size_t row = frow0 + (k < 255 ? (size_t)(S / 2 + 1 + k) : (size_t)(S + 255));
        v2u z; z.x = 0u; z.y = 0u;
#pragma unroll
        for (int j = 0; j < 16; ++j) *(v2u*)(FOLD + pg8::toff((int)row, 4 * F.lane + 256 * j, DM / 64)) = z; }
}

__global__ void __launch_bounds__(NWAVES * 64, 2) mega_fwd(Args args) {
    extern __shared__ __attribute__((aligned(16))) unsigned char lds_raw[];
    Frame F;
    F.lds = (LAS unsigned char*)lds_raw;
    F.tid = threadIdx.x; F.lane = F.tid & 63; F.wave = __builtin_amdgcn_readfirstlane(F.tid >> 6);
    F.G = gridDim.x; { const int bx = blockIdx.x; F.vcu = (F.G % 8 == 0) ? (bx % 8) * (F.G / 8) + bx / 8 : bx; }
    unsigned char* ws = args.ws;
    gu32* ctl = (gu32*)(ws + WS_CTL);
    volatile LAS unsigned* MISC = (volatile LAS unsigned*)(F.lds + MISC_OFF);
    for (int u = F.tid; u < (LDS_BYTES - LDSCTL_OFF) / 4; u += NWAVES * 64) ((LAS unsigned*)(F.lds + LDSCTL_OFF))[u] = 0u;
    __syncthreads();
    XcdBarrier bar; bar.bar = (unsigned*)(ctl + CW_BAR); bar.x = 0; bar.st = nullptr;
    if (N_LAUNCHES == 1) bar = xcd_barrier_post((unsigned*)(ctl + CW_BAR), MISC + 8);
    const int lo = args.ph_lo, hi = args.ph_hi;
#define IN(k) (lo <= (k) && (k) < hi)
#define SEAM(k) do { if (IN(k) && IN((k) + 1)) xcd_barrier(bar); } while (0)
    LAS unsigned char* ring = F.lds + RING_OFF;
    const int bx = (int)blockIdx.x;
    bf16* XN = (bf16*)(ws + WS_XN); bf16* BIG = (bf16*)(ws + WS_BIG);
    const float* xp = args.in[0]; const float* xs = args.in[1];

    if (IN(0)) { p0_prologue(F, args); } SEAM(0);
    if (IN(1)) { pg8::Gemm g{XN, (const bf16*)(ws + WS_WIN), 64, 64, DM, 0, 0, (size_t)256 * DM, (size_t)256 * DM, 32768, 32768}; pg8::Order S; S.init(MT / 256, 2 * DM / 256, 1, F.G, bx);
        pg8::EpiGelu E{BIG, 2 * DM}; pg8::gemm_phase<pg8::EpiGelu>(ring, g, S, E); } SEAM(1);
    if (IN(2)) { vstats_phase(F, args); xcd_barrier(bar); gate_phase(F, args); } SEAM(2);
    if (IN(3)) { pg8::Gemm g{XN, (const bf16*)(ws + WS_WOA), 64, 64, DM, 0, 0, (size_t)256 * DM, (size_t)256 * DM, 32768, 32768}; pg8::Order S; S.init(MT / 256, DM / 256, 1, F.G, bx);
        pg8::EpiRes E{xp, xs, M_P / 256, args.out, DM}; pg8::gemm_phase<pg8::EpiRes>(ring, g, S, E); } SEAM(3);
    if (IN(4)) { rmsnorm_rows<false>(F, args.out, args.out, MT, args.in[11], XN, nullptr); } SEAM(4);
    if (IN(5)) { pg8::Gemm g{XN, (const bf16*)(ws + WS_WGU), 64, 64, DM, 0, 0, (size_t)256 * DM, (size_t)256 * DM, 32768, 32768}; pg8::Order S; S.init(MT / 256, 2 * DFF / 256, 1, F.G, bx);
        pg8::EpiSwiglu E{BIG, DFF}; pg8::gemm_phase<pg8::EpiSwiglu>(ring, g, S, E); } SEAM(5);
    if (IN(6)) { pg8::Gemm g{BIG, (const bf16*)(ws + WS_WD), 64, 64, DFF, 0, 0, (size_t)256 * DFF, (size_t)256 * DFF, 32768, 32768}; pg8::Order S; S.init(MT / 256, DM / 256, 1, F.G, bx);
        pg8::EpiRes E{args.out, args.out, 1 << 30, args.out, DM}; pg8::gemm_phase<pg8::EpiRes>(ring, g, S, E); } SEAM(6);
    bf16* FOLD = BIG; bf16* TB = (bf16*)(ws + WS_BIG + BIG_T_OFF);
    const pg8::FoldGeom fgeo{NB_P * FT_P, FT_P, FT_S, KP_P, KP_S, NB_P};
    if (IN(7)) { fold_norm_phase(F, args.out, args.in[9], FOLD); } SEAM(7);
    if (IN(8)) { pg8::Gemm g{(const bf16*)(ws + WS_D512), FOLD, GD, 64, GD, 0, (size_t)8 * 16384, (size_t)256 * GD, (size_t)256 * DM, 128, 32768}; pg8::OrderFour S; S.init(NFT, NGRP, F.G, bx, fgeo);
        pg8::EpiFourA E{TB, fgeo}; pg8::gemm_phase<pg8::EpiFourA, pg8::OrderFour>(ring, g, S, E); } SEAM(8);
    if (IN(9)) {
        { pg8::Gemm g{(const bf16*)(ws + WS_ADP), TB, 64, 64, KP_P, 0, (size_t)DM * KP_P, (size_t)256 * KP_P, (size_t)256 * KP_P, 32768, 32768}; pg8::Order S; S.init(S_P / 256, DM / 256, NB_P, F.G, bx);
          pg8::EpiScale E{XN, DM, 0.0009765625f  , S_P}; pg8::gemm_phase<pg8::EpiScale>(ring, g, S, E); }
        { pg8::Gemm g{(const bf16*)(ws + WS_ADS), TB + (size_t)NB_P * DM * KP_P, 64, 64, KP_S, 0, (size_t)DM * KP_S, (size_t)256 * KP_S, (size_t)256 * KP_S, 32768, 32768}; pg8::Order S; S.init(S_S / 256, DM / 256, NB_S, F.G, bx);
          pg8::EpiScale E{XN + (size_t)M_P * DM, DM, 0.00069053396600248784f  , S_S}; pg8::gemm_phase<pg8::EpiScale>(ring, g, S, E); }
    } SEAM(9);
    if (IN(10)) { pg8::Gemm g{XN, (const bf16*)(ws + WS_WOB), 64, 64, DM, 0, 0, (size_t)256 * DM, (size_t)256 * DM, 32768, 32768}; pg8::Order S; S.init(MT / 256, DM / 256, 1, F.G, bx);
        pg8::EpiRes E{args.out, args.out, 1 << 30, args.out, DM}; pg8::gemm_phase<pg8::EpiRes>(ring, g, S, E); } SEAM(10);
    if (IN(11)) { rmsnorm_rows<false>(F, args.out, args.out, MT, args.in[11] + DM, XN, nullptr); } SEAM(11);
    if (IN(12)) { pg8::Gemm g{XN, (const bf16*)(ws + WS_WGU + WGU_BYTES), 64, 64, DM, 0, 0, (size_t)256 * DM, (size_t)256 * DM, 32768, 32768}; pg8::Order S; S.init(MT / 256, 2 * DFF / 256, 1, F.G, bx);
        pg8::EpiSwiglu E{BIG, DFF}; pg8::gemm_phase<pg8::EpiSwiglu>(ring, g, S, E); } SEAM(12);
    if (IN(13)) { pg8::Gemm g{BIG, (const bf16*)(ws + WS_WD + WD_BYTES), 64, 64, DFF, 0, 0, (size_t)256 * DFF, (size_t)256 * DFF, 32768, 32768}; pg8::Order S; S.init(MT / 256, DM / 256, 1, F.G, bx);
        pg8::EpiRes E{args.out, args.out, 1 << 30, args.out, DM}; pg8::gemm_phase<pg8::EpiRes>(ring, g, S, E); } SEAM(13);
    if (IN(14)) {
        rmsnorm_rows<true>(F, args.out, args.out, MT, args.in[15], nullptr, args.out);
        if (N_LAUNCHES == 1 && __hip_atomic_load((unsigned*)(ctl + CW_BAR) + XB_TMO, RLX_AGENT) != 0u) {
            const int gw = F.vcu * NWAVES + F.wave, NGW = F.G * NWAVES; const float q = __builtin_nanf("");
            for (int m = gw; m < MT; m += NGW) { f32x4* o = (f32x4*)(args.out + (size_t)m * DM) + F.lane;
#pragma unroll
                for (int j = 0; j < 16; ++j) o[64 * j] = (f32x4){q, q, q, q}; } }
    }
#undef IN
#undef SEAM
}

extern "C" void kernel_launch(void* const* d_in, const int* in_sizes, int n_in, void* d_out, int out_size, void* d_ws, size_t ws_size, hipStream_t stream) {
    static int grid = 0;
    if (grid == 0) {
        if (n_in != 16 || in_sizes[0] != M_P * DM || in_sizes[1] != M_S * DM || out_size != MT * DM || ws_size < WS_END) {
            fprintf(stderr, "kernel_launch: unexpected shapes (n_in %d, out %d, ws %zu, need %zu); nothing launched\n", n_in, out_size, ws_size, (size_t)WS_END); grid = -1; return; }
        int dev = 0, cus = 0, per_cu = 0;
        if (hipGetDevice(&dev) != hipSuccess || hipDeviceGetAttribute(&cus, hipDeviceAttributeMultiprocessorCount, dev) != hipSuccess) { grid = -1; return; }
        if (hipFuncSetAttribute((const void*)mega_fwd, hipFuncAttributeMaxDynamicSharedMemorySize, LDS_BYTES) != hipSuccess) { fprintf(stderr, "kernel_launch: hipFuncSetAttribute failed\n"); grid = -1; return; }
        if (hipOccupancyMaxActiveBlocksPerMultiprocessor(&per_cu, (const void*)mega_fwd, NWAVES * 64, LDS_BYTES) != hipSuccess || per_cu < 1)
            fprintf(stderr, "kernel_launch: note: occupancy query reports %d workgroups per CU\n", per_cu);
        (void)hipGetLastError();
        grid = cus;
    }
    if (grid < 0) return;
    if (hipMemsetAsync((char*)d_ws + WS_CTL, 0, CTL_ZERO_BYTES, stream) != hipSuccess) return;
    Args a{};
    for (int i = 0; i < 16; ++i) a.in[i] = (const float*)d_in[i];
    a.out = (float*)d_out; a.ws = (unsigned char*)d_ws;
    for (int li = 0; li < N_LAUNCHES; ++li) {
        a.ph_lo = (N_LAUNCHES == 1) ? 0 : li; a.ph_hi = (N_LAUNCHES == 1) ? N_PHASES : li + 1;
        hipLaunchKernelGGL(mega_fwd, dim3(grid), dim3(NWAVES * 64), LDS_BYTES, stream, a);
        const hipError_t le = hipPeekAtLastError();
        if (le != hipSuccess) { fprintf(stderr, "kernel_launch: launch %d failed: %s\n", li, hipGetErrorName(le)); break; }
    }
}
```
